# Optimizing an MI355X kernel written in HIP

```python
import jax, jax.numpy as jnp
from jax import lax
import numpy as np

D_MODEL = 2048
BATCH = 2
SEQ = 4096
DEPTH = 1

CHUNK = 64
D_RET = 1024
D_CONV = 1024
D_MIX = D_RET + D_CONV
N_RET_HEADS = 8
HEAD_DIM = D_RET // N_RET_HEADS
CONV_WIDTH = 3
D_IN_PROJ = 4 * D_RET + 3 * D_CONV
N_EXPERTS = 32
TOP_K = 4
D_FF = 2048
SWIGLU_LIMIT = 7.0
SWIGLU_ALPHA = 1.702
ROPE_BASE = 10000.0
EPS = 1e-6
EXPERT_BLOCK = 128

kernel_name = "hybrid_retention_shortconv_moe_adaln"


def rms_norm(x, g):
    xf = x.astype(jnp.float32)
    y = xf * lax.rsqrt(jnp.mean(xf * xf, axis=-1, keepdims=True) + EPS)
    return (y * g.astype(jnp.float32)).astype(x.dtype)


def rope(x, pos):
    half = x.shape[-1] // 2
    freqs = ROPE_BASE ** (-jnp.arange(half, dtype=jnp.float32) / half)
    ang = pos.astype(jnp.float32)[:, None] * freqs[None, :]
    cos = jnp.cos(ang)[:, None, :]
    sin = jnp.sin(ang)[:, None, :]
    x1, x2 = x[..., :half], x[..., half:]
    return jnp.concatenate([x1 * cos - x2 * sin, x2 * cos + x1 * sin], axis=-1)


def retention_chunkwise(q, k, v):
    b, t, h, dh = q.shape
    nc = t // CHUNK
    log_gamma = jnp.log1p(-jnp.exp2(-5.0 - jnp.arange(h, dtype=jnp.float32)))
    idx = jnp.arange(CHUNK, dtype=jnp.float32)
    dist = jnp.abs(idx[:, None] - idx[None, :])
    d_intra = jnp.exp(log_gamma[:, None, None] * dist)
    d_kv = jnp.exp(log_gamma[:, None] * (CHUNK - 1 - idx)[None])
    d_q = jnp.exp(log_gamma[:, None] * (idx + 1.0)[None])
    d_chunk = jnp.exp(log_gamma * CHUNK)
    qc = q.reshape(b, nc, CHUNK, h, dh)
    kc = k.reshape(b, nc, CHUNK, h, dh)
    vc = v.reshape(b, nc, CHUNK, h, dh)
    scores = jnp.einsum('bzqhd,bzkhd->bzhqk', qc, kc) * d_intra
    intra = jnp.einsum('bzhqk,bzkhe->bzqhe', scores, vc)
    kv = jnp.einsum('bzkhd,bzkhe,hk->zbhde', kc, vc, d_kv)

    def step(state, kv_z):
        return d_chunk[None, :, None, None] * state + kv_z, state

    _, s_prev = lax.scan(step, jnp.zeros((b, h, dh, dh), jnp.float32), kv)
    cross = jnp.einsum('bzqhd,zbhde,hq->bzqhe', qc, s_prev, d_q)
    return (intra + cross).reshape(b, t, h, dh)


def short_conv(u, w):
    return lax.conv_general_dilated(
        u, w[:, None, :].astype(u.dtype), window_strides=(1,),
        padding=[(CONV_WIDTH - 1, 0)],
        dimension_numbers=('NWC', 'WIO', 'NWC'),
        feature_group_count=u.shape[-1])


def hybrid_mixer(h, w_in, conv_w, w_out):
    b, t, _ = h.shape
    pos = jnp.arange(t)
    proj = h @ w_in
    q, k, v, g, bg, cg, u = jnp.split(
        proj, [D_RET, 2 * D_RET, 3 * D_RET, 4 * D_RET,
               4 * D_RET + D_CONV, 4 * D_RET + 2 * D_CONV], axis=-1)
    q = rope(q.reshape(b, t, N_RET_HEADS, HEAD_DIM).astype(jnp.float32), pos)
    k = rope(k.reshape(b, t, N_RET_HEADS, HEAD_DIM).astype(jnp.float32), pos) * (HEAD_DIM ** -0.5)
    v = v.reshape(b, t, N_RET_HEADS, HEAD_DIM).astype(jnp.float32)
    o = retention_chunkwise(q, k, v)
    mu = jnp.mean(o, axis=-1, keepdims=True)
    var = jnp.mean(jnp.square(o - mu), axis=-1, keepdims=True)
    o = ((o - mu) * lax.rsqrt(var + EPS)).reshape(b, t, D_RET).astype(h.dtype)
    y_ret = jax.nn.silu(g) * o
    y_conv = bg * short_conv(cg * u, conv_w)
    return jnp.concatenate([y_ret, y_conv], axis=-1) @ w_out


def moe_ffn(h, w_router, b_router, w_gate_up, b_gate_up, w_down, b_down):
    b, t, d = h.shape
    n = b * t
    xf = h.reshape(n, d)
    logits = xf.astype(jnp.float32) @ w_router.astype(jnp.float32) + b_router.astype(jnp.float32)
    top_val, top_idx = lax.top_k(logits, TOP_K)
    top_w = jax.nn.softmax(top_val, axis=-1)
    n_assign = n * TOP_K
    e_flat = top_idx.reshape(-1)
    tok_flat = jnp.repeat(jnp.arange(n, dtype=jnp.int32), TOP_K)
    w_flat = top_w.reshape(-1)
    order = jnp.argsort(e_flat)
    e_sorted, tok_sorted, w_sorted = e_flat[order], tok_flat[order], w_flat[order]
    counts = jnp.bincount(e_flat, length=N_EXPERTS)
    start = jnp.cumsum(counts) - counts
    padded = (counts + EXPERT_BLOCK - 1) // EXPERT_BLOCK * EXPERT_BLOCK
    padded_end = jnp.cumsum(padded)
    padded_start = padded_end - padded
    dest = padded_start[e_sorted] + jnp.arange(n_assign) - start[e_sorted]
    n_blocks = -(-n_assign // EXPERT_BLOCK) + N_EXPERTS
    p = n_blocks * EXPERT_BLOCK
    tok_buf = jnp.full((p,), n, jnp.int32).at[dest].set(tok_sorted)
    w_buf = jnp.zeros((p,), jnp.float32).at[dest].set(w_sorted)
    block_expert = jnp.minimum(
        jnp.searchsorted(padded_end, jnp.arange(n_blocks) * EXPERT_BLOCK, side='right'),
        N_EXPERTS - 1)
    x_pad = jnp.concatenate([xf, jnp.zeros((1, d), xf.dtype)], axis=0)

    def expert_block(args):
        tok, e = args
        xb = x_pad[tok]
        gu = xb @ w_gate_up[e] + b_gate_up[e]
        gate, up = gu[:, :D_FF], gu[:, D_FF:]
        gate = jnp.minimum(gate, SWIGLU_LIMIT)
        up = jnp.clip(up, -SWIGLU_LIMIT, SWIGLU_LIMIT)
        act = (up + 1.0) * (gate * jax.nn.sigmoid(SWIGLU_ALPHA * gate))
        return act @ w_down[e] + b_down[e]

    y_blocks = lax.map(expert_block, (tok_buf.reshape(n_blocks, EXPERT_BLOCK), block_expert))
    y = jnp.zeros((n + 1, d), h.dtype).at[tok_buf].add(
        y_blocks.reshape(p, d) * w_buf[:, None].astype(h.dtype))
    return y[:n].reshape(b, t, d)


def setup_inputs(seed: int = 0) -> dict:
    key = jax.random.key(seed)
    ks = jax.random.split(key, 16)
    f32 = jnp.float32
    nrm = lambda k, s, sc: jax.random.normal(k, s, f32) * sc
    return {
        "x": nrm(ks[0], (BATCH, SEQ, D_MODEL), 1.0),
        "c": nrm(ks[1], (BATCH, D_MODEL), 1.0),
        "norm1_g": 1.0 + nrm(ks[2], (DEPTH, D_MODEL), 0.01),
        "w_mod": nrm(ks[3], (DEPTH, D_MODEL, 6 * D_MODEL), 0.5 * D_MODEL ** -0.5),
        "b_mod": nrm(ks[4], (DEPTH, 6 * D_MODEL), 0.01),
        "w_in": nrm(ks[5], (DEPTH, D_MODEL, D_IN_PROJ), D_MODEL ** -0.5),
        "conv_w": nrm(ks[6], (DEPTH, CONV_WIDTH, D_CONV), CONV_WIDTH ** -0.5),
        "w_out": nrm(ks[7], (DEPTH, D_MIX, D_MODEL), D_MIX ** -0.5),
        "norm2_g": 1.0 + nrm(ks[8], (DEPTH, D_MODEL), 0.01),
        "w_router": nrm(ks[9], (DEPTH, D_MODEL, N_EXPERTS), D_MODEL ** -0.5),
        "b_router": nrm(ks[10], (DEPTH, N_EXPERTS), 0.01),
        "w_gate_up": nrm(ks[11], (DEPTH, N_EXPERTS, D_MODEL, 2 * D_FF), D_MODEL ** -0.5),
        "b_gate_up": nrm(ks[12], (DEPTH, N_EXPERTS, 2 * D_FF), 0.01),
        "w_down": nrm(ks[13], (DEPTH, N_EXPERTS, D_FF, D_MODEL), D_FF ** -0.5),
        "b_down": nrm(ks[14], (DEPTH, N_EXPERTS, D_MODEL), 0.01),
        "final_g": 1.0 + nrm(ks[15], (D_MODEL,), 0.01),
    }


def reference(x, c, norm1_g, w_mod, b_mod, w_in, conv_w, w_out, norm2_g,
              w_router, b_router, w_gate_up, b_gate_up, w_down, b_down, final_g):
    c_act = jax.nn.silu(c)
    for l in range(DEPTH):
        mod = c_act @ w_mod[l] + b_mod[l]
        shift1, scale1, gate1, shift2, scale2, gate2 = [
            m[:, None, :] for m in jnp.split(mod, 6, axis=-1)]
        h = rms_norm(x, norm1_g[l]) * (1.0 + scale1) + shift1
        x = x + gate1 * hybrid_mixer(h, w_in[l], conv_w[l], w_out[l])
        h = rms_norm(x, norm2_g[l]) * (1.0 + scale2) + shift2
        x = x + gate2 * moe_ffn(h, w_router[l], b_router[l], w_gate_up[l],
                                b_gate_up[l], w_down[l], b_down[l])
    return rms_norm(x, final_g)
```

```cpp
#include <hip/hip_runtime.h>
#include <cstdio>
#include <cstdint>

#ifndef MK_N_LAUNCHES
#define MK_N_LAUNCHES 1
#endif
#ifndef MOE_FP8
#define MOE_FP8 1
#endif
#ifndef NCONV2
#define NCONV2 9
#endif
#ifndef NCONV5
#define NCONV5 16
#endif
#ifndef NCONV8
#define NCONV8 4
#endif
#ifndef OUT_FP8
#define OUT_FP8 1
#endif
#ifndef PROBE_DUP
#define PROBE_DUP -1
#endif
#define RUN(k, ...) do { __VA_ARGS__; if (PROBE_DUP == (k)) { __VA_ARGS__; } } while (0)

#define GAS __attribute__((address_space(1)))
#define LAS __attribute__((address_space(3)))
typedef unsigned short bf16;
typedef unsigned v4u __attribute__((ext_vector_type(4)));
typedef unsigned v2u __attribute__((ext_vector_type(2)));
typedef float f32x4 __attribute__((ext_vector_type(4)));
typedef float f32x2 __attribute__((ext_vector_type(2)));
typedef float f32x16 __attribute__((ext_vector_type(16)));
typedef short bf16x8 __attribute__((ext_vector_type(8)));
typedef int v8i __attribute__((ext_vector_type(8)));
typedef int v4i __attribute__((ext_vector_type(4)));

constexpr int NBATCH = 2, SEQ = 4096, DM = 2048, MTOK = NBATCH * SEQ;
constexpr int DRET = 1024, NHEAD = 8, HD = 128, CHUNK = 64, NCHUNK = SEQ / CHUNK;
constexpr int NPROJ = 7168, NEXP = 32, TOPK = 4, DFF = 2048, CAP = 8192;
constexpr float EPS = 1e-6f;
constexpr int PER_PHASE = 11;
constexpr int N_LAUNCHES = MK_N_LAUNCHES;
constexpr int NWAVES = 8;
constexpr int MOE_ES = MOE_FP8 ? 1 : 2;
constexpr int MOE_G = 16 / MOE_ES;

constexpr size_t MiB = 1u << 20;
constexpr size_t WS_CTL = 0, CTL_ZERO_BYTES = 1 * MiB;
constexpr size_t WS_MOD = 2 * MiB;
constexpr size_t WS_COS = 3 * MiB, WS_SIN = 4 * MiB;
constexpr size_t WS_WRT = 5 * MiB;
constexpr size_t WS_WIN = 8 * MiB;
constexpr size_t WS_WOUT = 40 * MiB;
constexpr size_t WS_H = 64 * MiB;
constexpr size_t WS_PROJ = 96 * MiB;
constexpr size_t WS_ST = 208 * MiB;
constexpr size_t WS_Y = 240 * MiB;
constexpr size_t WS_X1 = 272 * MiB;
constexpr size_t WS_DEST = 336 * MiB, WS_WROW = 337 * MiB;
constexpr size_t WS_TKE = 338 * MiB, WS_TKW = 339 * MiB, WS_HIST = 340 * MiB;
constexpr size_t WS_CONTRIB = 344 * MiB;
constexpr size_t WS_WGU = 512 * MiB;
constexpr size_t WS_WDN = 1024 * MiB;
constexpr size_t WS_TT = 1280 * MiB;
constexpr size_t WS_CARRY = 1296 * MiB;
constexpr size_t WS_ACT = 2304 * MiB;
constexpr size_t WS_END = 3328 * MiB;
constexpr int CW_TMO = 0, CW_BAR = 4096, CW_CNT = 16384, CW_CHEAD = 16448, CW_DONE2 = 16512, CW_DONE5 = 16576, CW_CHEAD_DN = 16640, CW_DONE8 = 16704, CW_MODDONE = 16768;

constexpr int RING_BYTES = 131072;
constexpr int LDSCTL_OFF = RING_BYTES, MISC_OFF = LDSCTL_OFF + 320;
constexpr int LDS_BYTES = 147456;

__device__ __forceinline__ unsigned cvt_pk_bf16(float lo, float hi) { unsigned r; asm volatile("v_cvt_pk_bf16_f32 %0, %1, %2" : "=v"(r) : "v"(lo), "v"(hi)); return r; }
__device__ __forceinline__ float bflo(unsigned w) { return __uint_as_float(w << 16); }
__device__ __forceinline__ float bfhi(unsigned w) { return __uint_as_float(w & 0xffff0000u); }
__device__ __forceinline__ float wave_sum(float v) {
#pragma unroll
    for (int o = 1; o < 64; o <<= 1) v += __shfl_xor(v, o);
    return v;
}
__device__ __forceinline__ unsigned pk4_fp8(float a, float b, float c, float d) {
    unsigned w = 0; w = __builtin_amdgcn_cvt_pk_fp8_f32(a, b, w, false); w = __builtin_amdgcn_cvt_pk_fp8_f32(c, d, w, true); return w;
}
__device__ __forceinline__ float lg2gamma(int h) {
    const float e = __builtin_amdgcn_exp2f((float)(-5 - h));
    const float s = e * (1.f + e * (0.5f + e * (0.33333334f + e * (0.25f + e * (0.2f + e * (0.16666667f + e * 0.14285715f))))));
    return -s * 1.4426950408889634f;
}
#define LDS_WAIT() asm volatile("s_waitcnt lgkmcnt(0)" ::: "memory")
#define VM_WAIT() asm volatile("s_waitcnt vmcnt(0)" ::: "memory")

#define XB_TMO      128
#define XB_XCNT(j)  (256  + 64 * (j))
#define XB_XSUB(j)  (1280 + 64 * (j))
#define XB_XGEN(j)  (2304 + 64 * (j))
#define XB_TOP      3328
#define XB_TOPGEN   3392
#define XCD_BAR_WORDS 3456
#define XB_SPIN_CAP (1u << 18)
__device__ __forceinline__ unsigned xb_ld(unsigned* p)              { return __hip_atomic_load(p, __ATOMIC_RELAXED, __HIP_MEMORY_SCOPE_AGENT); }
__device__ __forceinline__ unsigned xb_add(unsigned* p, unsigned v) { return __hip_atomic_fetch_add(p, v, __ATOMIC_RELAXED, __HIP_MEMORY_SCOPE_AGENT); }
__device__ __forceinline__ unsigned xb_xcc_id() { return (unsigned)__builtin_amdgcn_s_getreg((3 << 11) | 20) & 0xFu; }
#define XB_SPIN(cond, bar) do { unsigned _sp = 0; while (cond) { __builtin_amdgcn_s_sleep(1); \
    if ((++_sp & 255u) == 0u) { if (xb_ld(&(bar)[XB_TMO])) break; if (_sp > XB_SPIN_CAP) { atomicAdd(&(bar)[XB_TMO], 1u); break; } } } } while (0)
struct XcdBarrier { unsigned* bar; unsigned x; volatile LAS unsigned* st; };
__device__ __forceinline__ XcdBarrier xcd_barrier_post(unsigned* bar, volatile LAS unsigned* st) {
    XcdBarrier b; b.bar = bar; b.x = xb_xcc_id(); b.st = st;
    if (threadIdx.x == 0) (void)xb_add(&bar[XB_XCNT(b.x)], 1u);
    return b;
}
__device__ __forceinline__ void xcd_barrier_complete(unsigned* bar, unsigned x, unsigned& nloc, unsigned& nx) {
    const unsigned G = gridDim.x * gridDim.y * gridDim.z;
    unsigned sum, cnt, mine, sp = 0u;
    for (;;) {
        sum = 0u; cnt = 0u; mine = 0u;
#pragma unroll
        for (unsigned j = 0; j < 16; ++j) { const unsigned c = xb_ld(&bar[XB_XCNT(j)]); sum += c; cnt += (c > 0u) ? 1u : 0u; mine = (j == x) ? c : mine; }
        if (sum == G) break;
        __builtin_amdgcn_s_sleep(1);
        if ((++sp & 255u) == 0u) { if (xb_ld(&bar[XB_TMO])) break; if (sp > XB_SPIN_CAP) { atomicAdd(&bar[XB_TMO], 1u); break; } }
    }
    nloc = mine > 0u ? mine : 1u; nx = cnt > 0u ? cnt : 1u;
}
__device__ __forceinline__ void xcd_barrier(const XcdBarrier& b) {
    asm volatile("s_waitcnt vmcnt(0)" ::: "memory");
    __syncthreads();
    if (threadIdx.x == 0) {
        unsigned* bar = b.bar;
        __builtin_amdgcn_s_waitcnt(0);
        unsigned nloc = b.st[0], nx = b.st[1];
        if (nloc == 0u) { xcd_barrier_complete(bar, b.x, nloc, nx); b.st[0] = nloc; b.st[1] = nx; }
        const unsigned old = xb_add(&bar[XB_XSUB(b.x)], 1u);
        const unsigned gen = old / nloc;
        if (old + 1u == (gen + 1u) * nloc) {
            __builtin_amdgcn_fence(__ATOMIC_RELEASE, "agent");
            asm volatile("s_waitcnt vmcnt(0)" ::: "memory");
            const unsigned og = xb_add(&bar[XB_TOP], 1u);
            const unsigned tg = og / nx;
            if (og + 1u == (tg + 1u) * nx) xb_add(&bar[XB_TOPGEN], 1u);
            else XB_SPIN(xb_ld(&bar[XB_TOPGEN]) == tg, bar);
            __builtin_amdgcn_fence(__ATOMIC_ACQUIRE, "agent");
            xb_add(&bar[XB_XGEN(b.x)], 1u);
            asm volatile("s_waitcnt vmcnt(0)" ::: "memory");
        } else {
            XB_SPIN(xb_ld(&bar[XB_XGEN(b.x)]) == gen, bar);
            __builtin_amdgcn_fence(__ATOMIC_ACQUIRE, "agent");
            asm volatile("s_waitcnt vmcnt(0)" ::: "memory");
        }
    }
    __syncthreads();
}

namespace pg8 {
constexpr int BM = 256, HALF = 128, HTB = HALF * 128, STAGE_BYTES = 8 * HTB, NXCD = 8, WGM = 8;
__host__ __device__ __forceinline__ int lds_byte(int r, int c) { const int st = (r >> 4) * 2 + (c >> 5), rr = r & 15, cc = c & 31, ob = rr * 64 + cc * 2; return st * 1024 + (ob ^ (((ob >> 9) & 1) << 5)); }
__host__ __device__ __forceinline__ void stage_rc(int b, int& R, int& C) { const int st = b / 1024, sb = b % 1024, swz = sb ^ (((sb >> 9) & 1) << 5); R = (st >> 1) * 16 + swz / 64; C = (st & 1) * 32 + (swz % 64) / 2; }
__host__ __device__ __forceinline__ int perm32(int rho) { const int n = rho >> 4, i = rho & 15; return 8 * (i >> 2) + 4 * n + (i & 3); }

struct Unit { unsigned a, b0, b1; int row0, pn, e, cnt; };

struct DenseOrder {
    int KB, nM, nN, nwg, G, c; const int* rowtok = nullptr;
    __device__ void init(int KB_, int M, int N, int G_, int c_) { KB = KB_; nM = M / BM; nN = N / BM; nwg = nM * nN; G = G_; c = c_; }
    __device__ bool next(int i, Unit& u) const {
        const long L = (long)i * G + c; if (L >= nwg) return false;
        int wgid = (int)L; { const int q = nwg / NXCD, r = nwg % NXCD, xcd = wgid % NXCD, off = wgid / NXCD; wgid = (xcd < r ? xcd * (q + 1) : r * (q + 1) + (xcd - r) * q) + off; }
        const int nig = WGM * nN, gid = wgid / nig, fm = gid * WGM, gsz = (nM - fm) < WGM ? (nM - fm) : WGM;
        const int pm = fm + ((wgid % nig) % gsz), pn = (wgid % nig) / gsz;
        u.a = (unsigned)pm * BM * KB; u.b0 = (unsigned)pn * BM * 16; u.b1 = u.b0 + HALF * 16; u.row0 = pm * BM; u.pn = pn; u.e = 0; u.cnt = 0x7fffffff; return true;
    }
};

template <class Epi, class Sched, bool FP8, bool GATHER = false>
__device__ __forceinline__ void gemm_phase(LAS unsigned char* lds, const void* Abase, const void* Bbase, const int KB  , const int NB  , const Sched& S, const Epi& E) {
    const int tid = threadIdx.x, wid = __builtin_amdgcn_readfirstlane(tid >> 6), lane = tid & 63, wr = wid >> 2, wc = wid & 3, fr = lane & 15, fq = lane >> 4;
    const int nt = KB / 128;
    unsigned voffA[2], voffB[2];
#pragma unroll
    for (int i = 0; i < 2; ++i) { int R, C; stage_rc(tid * 16 + i * 8192, R, C); const int Rb = Epi::PERM ? ((R & ~31) + perm32(R & 31)) : R;
        voffA[i] = (unsigned)(R * KB + C * 2); voffB[i] = (unsigned)(((C >> 3) * NB + Rb) * 16); }
    unsigned vA[2][2] = {{0u, 0u}, {0u, 0u}};
    LAS int* TOK = (LAS int*)(lds + STAGE_BYTES + 1024);
#define PG8_GATHER_OFFS() do { _Pragma("unroll") for (int _h = 0; _h < 2; ++_h) _Pragma("unroll") for (int _i = 0; _i < 2; ++_i) { int R_, C_; stage_rc(tid * 16 + _i * 8192, R_, C_); \
        vA[_h][_i] = (unsigned)TOK[_h * HALF + R_] * (unsigned)KB + (unsigned)(C_ * 2); } } while (0)
#define PG8_FILL_TOK(un) do { if (tid < 256) { const int r_ = (un).row0 + tid; TOK[tid] = (r_ < (un).cnt) ? (S.rowtok[(size_t)(un).e * CAP + r_] >> 2) : 0; } } while (0)
    const unsigned kstepA = 128, kstepB = (unsigned)8 * NB * 16;
    const unsigned hstepA = (unsigned)HALF * KB;
    const __amdgpu_buffer_rsrc_t rA = __builtin_amdgcn_make_buffer_rsrc((void*)Abase, 0, 0xfffffff0, 0x00020000);
    const __amdgpu_buffer_rsrc_t rB = __builtin_amdgcn_make_buffer_rsrc((void*)Bbase, 0, 0xfffffff0, 0x00020000);
    const unsigned ldsw = (unsigned)wid * 1024u;
    const int aoff = lds_byte(wr * 64 + fr, fq * 8), boff = lds_byte(wc * 32 + fr, fq * 8);
#define PG8_SA(b, h) (((b) * 2 + (h)) * HTB)
#define PG8_SB(b, h) ((4 + (b) * 2 + (h)) * HTB)
#define PG8_STAGE(bufoff, rs, soff, voff) do { _Pragma("unroll") for (int _i = 0; _i < 2; ++_i) \
        __builtin_amdgcn_raw_ptr_buffer_load_lds(rs, (LAS void*)(lds + (bufoff) + ldsw + _i * 8192), 16, (int)(voff)[_i], (int)(soff), 0, 0); } while (0)
#define PG8_STAGE_A(bufoff, h, soff) do { if constexpr (GATHER) { PG8_STAGE(bufoff, rA, soff, vA[h]); } else { PG8_STAGE(bufoff, rA, (soff) + (h) * hstepA, voffA); } } while (0)
#define PG8_LD8(p) __builtin_shufflevector(*(const LAS v4i*)(p), *(const LAS v4i*)((p) + 1024), 0, 1, 2, 3, 4, 5, 6, 7)
#define PG8_LDA(dst, b, h) do { _Pragma("unroll") for (int m = 0; m < 4; ++m) dst[m] = PG8_LD8(lds + PG8_SA(b, h) + aoff + m * 2048); } while (0)
#define PG8_LDB(dst, b, h) do { _Pragma("unroll") for (int n = 0; n < 2; ++n) dst[n] = PG8_LD8(lds + PG8_SB(b, h) + boff + n * 2048); } while (0)
#define PG8_LO(v) __builtin_bit_cast(bf16x8, __builtin_shufflevector(v, v, 0, 1, 2, 3))
#define PG8_HI(v) __builtin_bit_cast(bf16x8, __builtin_shufflevector(v, v, 4, 5, 6, 7))
#define PG8_MMA(ai, bj, At, Bt) do { __builtin_amdgcn_s_setprio(1); _Pragma("unroll") for (int m = 0; m < 4; ++m) _Pragma("unroll") for (int n = 0; n < 2; ++n) { \
        if constexpr (FP8) { asm volatile("v_mfma_scale_f32_16x16x128_f8f6f4 %0, %1, %2, %0, %3, %4 op_sel_hi:[0,0,0]" : "+v"(acc[ai][bj][m][n]) : "v"(Bt[n]), "v"(At[m]), "v"(sclB), "v"(sclA)); } \
        else { acc[ai][bj][m][n] = __builtin_amdgcn_mfma_f32_16x16x32_bf16(PG8_LO(Bt[n]), PG8_LO(At[m]), acc[ai][bj][m][n], 0, 0, 0); \
               acc[ai][bj][m][n] = __builtin_amdgcn_mfma_f32_16x16x32_bf16(PG8_HI(Bt[n]), PG8_HI(At[m]), acc[ai][bj][m][n], 0, 0, 0); } } \
        __builtin_amdgcn_s_setprio(0); } while (0)
#define PG8_WAIT_V(n) asm volatile("s_waitcnt vmcnt(" #n ")" ::: "memory")
#define PG8_WAIT_L(n) asm volatile("s_waitcnt lgkmcnt(" #n ")" ::: "memory")
#define PG8_BAR __builtin_amdgcn_s_barrier()
#define PG8_SCHED __builtin_amdgcn_sched_barrier(0)
    Unit cur, nxt; int ui = 0;
    if (!S.next(0, cur)) return;
    const int sclB = E.scale_b, sclA = 0x7f7f7f7f;
    f32x4 acc[2][2][4][2];
#pragma unroll
    for (int a = 0; a < 2; ++a)
#pragma unroll
        for (int b = 0; b < 2; ++b)
#pragma unroll
            for (int m = 0; m < 4; ++m)
#pragma unroll
                for (int n = 0; n < 2; ++n) acc[a][b][m][n] = (f32x4){0.f, 0.f, 0.f, 0.f};
    v8i At[4], B0[2], B1[2];
    unsigned cA = cur.a, cB0 = cur.b0, cB1 = cur.b1;
    if constexpr (GATHER) { PG8_FILL_TOK(cur); PG8_WAIT_L(0); PG8_BAR; PG8_GATHER_OFFS(); PG8_WAIT_L(0); PG8_BAR; }
    PG8_STAGE(PG8_SB(0, 0), rB, cB0, voffB); PG8_STAGE(PG8_SB(0, 1), rB, cB1, voffB); PG8_STAGE_A(PG8_SA(0, 0), 0, cA); PG8_STAGE_A(PG8_SA(0, 1), 1, cA);
    if (wr == 1) PG8_BAR;
    PG8_WAIT_V(2); PG8_BAR;
    PG8_STAGE(PG8_SB(1, 0), rB, cB0 + kstepB, voffB); PG8_STAGE_A(PG8_SA(1, 0), 0, cA + kstepA); PG8_STAGE(PG8_SB(1, 1), rB, cB1 + kstepB, voffB);
    PG8_WAIT_V(6); PG8_BAR;
    for (;;) {
        const bool has_next = S.next(ui + 1, nxt);
        const unsigned nA = has_next ? nxt.a : cA, nB0 = has_next ? nxt.b0 : cB0, nB1 = has_next ? nxt.b1 : cB1;
        if constexpr (GATHER) { if (has_next) PG8_FILL_TOK(nxt); }
        for (int t = 0; t < nt; t += 2) {
            const bool last = (t == nt - 2);
            const unsigned a1 = cA + (unsigned)(t + 1) * kstepA;
            const unsigned a2 = last ? nA : cA + (unsigned)(t + 2) * kstepA;
            const unsigned b20 = last ? nB0 : cB0 + (unsigned)(t + 2) * kstepB, b21 = last ? nB1 : cB1 + (unsigned)(t + 2) * kstepB;
            const unsigned a3 = a2 + kstepA, b30 = b20 + kstepB, b31 = b21 + kstepB;
            PG8_LDB(B0, 0, 0); PG8_LDB(B1, 0, 1); PG8_SCHED; PG8_LDA(At, 0, 0); PG8_STAGE_A(PG8_SA(1, 1), 1, a1);
            PG8_WAIT_V(8); PG8_WAIT_L(0); PG8_BAR; PG8_MMA(0, 0, At, B0); PG8_MMA(0, 1, At, B1); PG8_BAR; PG8_SCHED;
            if constexpr (GATHER) { if (last && has_next) PG8_GATHER_OFFS(); }
            PG8_LDA(At, 0, 1); PG8_STAGE(PG8_SB(0, 0), rB, b20, voffB); PG8_STAGE(PG8_SB(0, 1), rB, b21, voffB); PG8_STAGE_A(PG8_SA(0, 0), 0, a2);
            PG8_WAIT_V(8); PG8_WAIT_L(0); PG8_BAR; PG8_MMA(1, 0, At, B0); PG8_MMA(1, 1, At, B1); PG8_BAR; PG8_SCHED;
            PG8_LDB(B0, 1, 0); PG8_LDB(B1, 1, 1); PG8_SCHED; PG8_LDA(At, 1, 0); PG8_STAGE_A(PG8_SA(0, 1), 1, a2);
            PG8_WAIT_V(8); PG8_WAIT_L(0); PG8_BAR; PG8_MMA(0, 0, At, B0); PG8_MMA(0, 1, At, B1); PG8_BAR; PG8_SCHED;
            PG8_LDA(At, 1, 1); PG8_STAGE(PG8_SB(1, 0), rB, b30, voffB); PG8_STAGE(PG8_SB(1, 1), rB, b31, voffB); PG8_STAGE_A(PG8_SA(1, 0), 0, a3);
            PG8_WAIT_V(8); PG8_WAIT_L(0); PG8_BAR; PG8_MMA(1, 0, At, B0); PG8_MMA(1, 1, At, B1); PG8_BAR; PG8_SCHED;
        }
        if constexpr (FP8) { asm volatile("s_nop 15\n\ts_nop 15"); }
        if (wr == 0) PG8_BAR;
        { int tz = threadIdx.x; asm volatile("" : "+v"(tz));
          E(acc, cur, wr, wc, tz & 15, (tz & 63) >> 4); }
        if (!has_next) break;
#pragma unroll
        for (int a = 0; a < 2; ++a)
#pragma unroll
            for (int b = 0; b < 2; ++b)
#pragma unroll
                for (int m = 0; m < 4; ++m)
#pragma unroll
                    for (int n = 0; n < 2; ++n) acc[a][b][m][n] = (f32x4){0.f, 0.f, 0.f, 0.f};
        cur = nxt; cA = nA; cB0 = nB0; cB1 = nB1; ++ui;
        if (wr == 1) PG8_BAR;
    }
    PG8_WAIT_V(0);
    PG8_BAR;
#undef PG8_SA
#undef PG8_SB
#undef PG8_STAGE
#undef PG8_LDA
#undef PG8_STAGE_A
#undef PG8_GATHER_OFFS
#undef PG8_FILL_TOK
#undef PG8_LD8
#undef PG8_LO
#undef PG8_HI
#undef PG8_LDB
#undef PG8_MMA
#undef PG8_WAIT_V
#undef PG8_WAIT_L
#undef PG8_BAR
#undef PG8_SCHED
}

struct EpiProj {
    static constexpr bool PERM = true; int scale_b;
    bf16* O; int ldc;
    __device__ __forceinline__ void operator()(const f32x4 (&acc)[2][2][4][2], const Unit& u, int wr, int wc, int fr, int fq) const {
        const int row0 = u.row0 + wr * 64 + fr, col0 = u.pn * BM + wc * 32 + 8 * fq;
#pragma unroll
        for (int ai = 0; ai < 2; ++ai)
#pragma unroll
            for (int m = 0; m < 4; ++m) { bf16* rowp = O + (size_t)(row0 + ai * HALF + m * 16) * ldc + col0;
#pragma unroll
                for (int bj = 0; bj < 2; ++bj) { const f32x4 v0 = acc[ai][bj][m][0], v1 = acc[ai][bj][m][1];
                    v4u w; w.x = cvt_pk_bf16(v0[0], v0[1]); w.y = cvt_pk_bf16(v0[2], v0[3]); w.z = cvt_pk_bf16(v1[0], v1[1]); w.w = cvt_pk_bf16(v1[2], v1[3]);
                    *(v4u*)(rowp + bj * HALF) = w; } }
    }
};
struct EpiDelta {
    static constexpr bool PERM = true; int scale_b;
    const float* mod; bf16* out;
    __device__ __forceinline__ void operator()(const f32x4 (&acc)[2][2][4][2], const Unit& u, int wr, int wc, int fr, int fq) const {
        const int row0 = u.row0 + wr * 64 + fr, col0 = u.pn * BM + wc * 32 + 8 * fq;
        const int b = u.row0 >> 12;
        const float* g = mod + (size_t)b * 12288 + 4096 + col0;
        f32x4 gv[2][2];
#pragma unroll
        for (int bj = 0; bj < 2; ++bj)
#pragma unroll
            for (int n = 0; n < 2; ++n) gv[bj][n] = *(const f32x4*)(g + bj * HALF + 4 * n);
#pragma unroll
        for (int ai = 0; ai < 2; ++ai)
#pragma unroll
            for (int m = 0; m < 4; ++m) { bf16* rowp = out + (size_t)(row0 + ai * HALF + m * 16) * DM + col0;
#pragma unroll
                for (int bj = 0; bj < 2; ++bj) { const f32x4 v0 = acc[ai][bj][m][0] * gv[bj][0], v1 = acc[ai][bj][m][1] * gv[bj][1];
                    v4u w; w.x = cvt_pk_bf16(v0[0], v0[1]); w.y = cvt_pk_bf16(v0[2], v0[3]); w.z = cvt_pk_bf16(v1[0], v1[1]); w.w = cvt_pk_bf16(v1[2], v1[3]);
                    *(v4u*)(rowp + bj * HALF) = w; } }
    }
};
struct EpiGateUp {
    static constexpr bool PERM = true; int scale_b;
    const float* bgu; unsigned char* act;
    __device__ __forceinline__ void operator()(const f32x4 (&acc)[2][2][4][2], const Unit& u, int wr, int wc, int fr, int fq) const {
        const int c8 = u.pn * HALF + wc * 32 + 8 * fq;
        const float* bb = bgu + (size_t)u.e * 4096 + c8;
        const f32x4 bg0 = *(const f32x4*)(bb), bg1 = *(const f32x4*)(bb + 4), bu0 = *(const f32x4*)(bb + 2048), bu1 = *(const f32x4*)(bb + 2052);
        asm volatile("" :: "v"(bg0), "v"(bg1), "v"(bu0), "v"(bu1));
#pragma unroll
        for (int ai = 0; ai < 2; ++ai)
#pragma unroll
            for (int m = 0; m < 4; ++m) { const int row = u.row0 + ai * HALF + wr * 64 + m * 16 + fr;
                float o[8];
#pragma unroll
                for (int n = 0; n < 2; ++n) { const f32x4 gt = acc[ai][0][m][n] + (n ? bg1 : bg0), up = acc[ai][1][m][n] + (n ? bu1 : bu0);
#pragma unroll
                    for (int j = 0; j < 4; ++j) { const float gc = fminf(gt[j], 7.0f), uc = fminf(fmaxf(up[j], -7.0f), 7.0f);
                        const float sg = __builtin_amdgcn_rcpf(1.0f + __builtin_amdgcn_exp2f(-1.702f * 1.4426950408889634f * gc));
                        o[n * 4 + j] = (uc + 1.0f) * (gc * sg); } }
                if (row < u.cnt) {
                    const size_t off = ((size_t)u.e * CAP + row) * DFF + c8;
                    if constexpr (MOE_FP8) { v2u w; w.x = pk4_fp8(o[0], o[1], o[2], o[3]); w.y = pk4_fp8(o[4], o[5], o[6], o[7]); __builtin_nontemporal_store(w, (v2u*)(act + off)); }
                    else { v4u w; w.x = cvt_pk_bf16(o[0], o[1]); w.y = cvt_pk_bf16(o[2], o[3]); w.z = cvt_pk_bf16(o[4], o[5]); w.w = cvt_pk_bf16(o[6], o[7]); *(v4u*)(act + off * 2) = w; }
                } }
    }
};
struct EpiDown {
    static constexpr bool PERM = true; int scale_b;
    const float* bdn; const int* dest; const float* wrow; unsigned char* contrib;
    __device__ __forceinline__ void operator()(const f32x4 (&acc)[2][2][4][2], const Unit& u, int wr, int wc, int fr, int fq) const {
        const int col0 = u.pn * BM + wc * 32 + 8 * fq;
        const float* bb = bdn + (size_t)u.e * DM + col0;
        f32x4 bv[2][2];
#pragma unroll
        for (int bj = 0; bj < 2; ++bj)
#pragma unroll
            for (int n = 0; n < 2; ++n) bv[bj][n] = *(const f32x4*)(bb + bj * HALF + 4 * n);
        int dd[2][4]; float ww[2][4];
#pragma unroll
        for (int ai = 0; ai < 2; ++ai)
#pragma unroll
            for (int m = 0; m < 4; ++m) { const size_t ix = (size_t)u.e * CAP + (u.row0 + ai * HALF + wr * 64 + m * 16 + fr); dd[ai][m] = dest[ix]; ww[ai][m] = wrow[ix]; }
        asm volatile("" :: "v"(bv[0][0]), "v"(bv[0][1]), "v"(bv[1][0]), "v"(bv[1][1]));
        asm volatile("" :: "v"(dd[0][0]), "v"(dd[0][1]), "v"(dd[0][2]), "v"(dd[0][3]), "v"(dd[1][0]), "v"(dd[1][1]), "v"(dd[1][2]), "v"(dd[1][3]));
        asm volatile("" :: "v"(ww[0][0]), "v"(ww[0][1]), "v"(ww[0][2]), "v"(ww[0][3]), "v"(ww[1][0]), "v"(ww[1][1]), "v"(ww[1][2]), "v"(ww[1][3]));
#pragma unroll
        for (int ai = 0; ai < 2; ++ai)
#pragma unroll
            for (int m = 0; m < 4; ++m) { const int row = u.row0 + ai * HALF + wr * 64 + m * 16 + fr;
                if (row < u.cnt) {
                    const float w = ww[ai][m] * 16.0f;
                    unsigned char* rowp = contrib + (size_t)dd[ai][m] * DM + col0;
#pragma unroll
                    for (int bj = 0; bj < 2; ++bj) { const f32x4 v0 = (acc[ai][bj][m][0] + bv[bj][0]) * w, v1 = (acc[ai][bj][m][1] + bv[bj][1]) * w;
                        v2u o; o.x = pk4_fp8(v0[0], v0[1], v0[2], v0[3]); o.y = pk4_fp8(v1[0], v1[1], v1[2], v1[3]);
                        *(v2u*)(rowp + bj * HALF) = o; } } }
    }
};
struct MoeOrder {
    const LAS int* tp; const LAS int* cn; int npn, G, c; unsigned wstride; int gateup; const int* rowtok;
    __device__ bool next(int i, Unit& u) const {
        const int L = i * G + c; const int total = tp[NEXP] * npn; if (L >= total) return false;
        int tile = L / npn, pn = L - tile * npn;
        if (npn == 16) {
            const int nfull = tp[NEXP] >> 2, sb = L >> 6;
            if (sb < nfull) { const int r = L & 63; tile = sb * 4 + ((r & 31) >> 3); pn = (r >> 5) * 8 + (r & 7); }
        }
        int e = 0;
#pragma unroll 1
        for (int s = 16; s > 0; s >>= 1) if (tp[e + s] <= tile) e += s;
        const int mt = tile - tp[e];
        u.a = gateup ? 0u : ((unsigned)e * CAP + (unsigned)mt * BM) * (unsigned)(DFF * MOE_ES);
        const unsigned wb = (unsigned)e * wstride;
        if (gateup) { u.b0 = wb + (unsigned)pn * HALF * 16; u.b1 = wb + (unsigned)(2048 + pn * HALF) * 16; }
        else { u.b0 = wb + (unsigned)pn * BM * 16; u.b1 = u.b0 + HALF * 16; }
        u.row0 = mt * BM; u.pn = pn; u.e = e; u.cnt = cn[e]; return true;
    }
};
}

struct Frame {
    LAS unsigned char* lds;
    unsigned* ctl;
    int tid, lane, wave, vcu, G;
    const float *x, *c, *norm1_g, *w_mod, *b_mod, *w_in, *conv_w, *w_out, *norm2_g, *w_router, *b_router, *w_gu, *b_gu, *w_dn, *b_dn, *final_g;
    float* out; unsigned char* ws;
};

template <int ES>
__device__ __forceinline__ void conv_item(const float* __restrict__ src, int N, unsigned char* __restrict__ dst, int kg, int nb, int lane, float scale) {
    constexpr int GK = 16 / ES;
    const int n0 = nb * 256 + lane * 4;
    const float* s = src + (size_t)kg * GK * N + n0;
    f32x4 v[GK];
#pragma unroll
    for (int r = 0; r < GK; ++r) v[r] = __builtin_nontemporal_load((const f32x4*)(s + (size_t)r * N));
    v4u* d = (v4u*)(dst + ((size_t)kg * N + n0) * 16);
#pragma unroll
    for (int j = 0; j < 4; ++j) {
        v4u o;
        if constexpr (ES == 2) { o.x = cvt_pk_bf16(v[0][j], v[1][j]); o.y = cvt_pk_bf16(v[2][j], v[3][j]); o.z = cvt_pk_bf16(v[4][j], v[5][j]); o.w = cvt_pk_bf16(v[6][j], v[7][j]); }
        else { o.x = pk4_fp8(v[0][j] * scale, v[1][j] * scale, v[2][j] * scale, v[3][j] * scale); o.y = pk4_fp8(v[4][j] * scale, v[5][j] * scale, v[6][j] * scale, v[7][j] * scale);
               o.z = pk4_fp8(v[8 % GK][j] * scale, v[9 % GK][j] * scale, v[10 % GK][j] * scale, v[11 % GK][j] * scale); o.w = pk4_fp8(v[12 % GK][j] * scale, v[13 % GK][j] * scale, v[14 % GK][j] * scale, v[15 % GK][j] * scale); }
        d[j] = o;
    }
}
template <int ES>
__device__ __forceinline__ void conv_matrix(Frame& F, const float* src, int K, int N, unsigned char* dst, int nmat, float scale) {
    constexpr int GK = 16 / ES;
    const int gw = F.vcu * NWAVES + F.wave, NGW = F.G * NWAVES;
    const int nnb = N / 256, per = (K / GK) * nnb; const long total = (long)per * nmat;
    for (long it = gw; it < total; it += NGW) {
        const int mat = (int)(it / per), r = (int)(it - (long)mat * per), kg = r / nnb, nb = r - kg * nnb;
        conv_item<ES>(src + (size_t)mat * K * N, N, dst + (size_t)mat * K * N * ES, kg, nb, F.lane, scale);
    }
}
__device__ __forceinline__ void p0_prologue(Frame& F) {
    if (F.vcu < 192) {
        LAS float* sc = (LAS float*)F.lds;
        LAS float* red = (LAS float*)(F.lds + 16384);
        const int c4 = F.tid & 15, kq = F.tid >> 4, col = F.vcu * 64 + c4 * 4;
        f32x4 wp[8];
#pragma unroll
        for (int j = 0; j < 8; ++j) wp[j] = __builtin_nontemporal_load((const f32x4*)(F.w_mod + (size_t)(kq + 32 * j) * 12288 + col));
        for (int i = F.tid; i < 4096; i += 512) { const float v = F.c[i]; sc[i] = v / (1.0f + __expf(-v)); }
        __syncthreads();
        f32x4 a0 = {0.f, 0.f, 0.f, 0.f}, a1 = {0.f, 0.f, 0.f, 0.f};
#pragma unroll
        for (int j = 0; j < 8; ++j) { a0 += wp[j] * sc[kq + 32 * j]; a1 += wp[j] * sc[2048 + kq + 32 * j]; }
#pragma unroll 8
        for (int k = kq + 256; k < DM; k += 32) { const f32x4 w = __builtin_nontemporal_load((const f32x4*)(F.w_mod + (size_t)k * 12288 + col)); a0 += w * sc[k]; a1 += w * sc[2048 + k]; }
#pragma unroll
        for (int j = 0; j < 4; ++j) { red[(kq * 2 + 0) * 64 + c4 * 4 + j] = a0[j]; red[(kq * 2 + 1) * 64 + c4 * 4 + j] = a1[j]; }
        __syncthreads();
        if (F.tid < 128) { const int b = F.tid >> 6, cc = F.tid & 63; float s = 0.f;
#pragma unroll 8
            for (int q = 0; q < 32; ++q) s += red[(q * 2 + b) * 64 + cc];
            ((float*)(F.ws + WS_MOD))[b * 12288 + F.vcu * 64 + cc] = s + F.b_mod[F.vcu * 64 + cc]; }
        __syncthreads();
        if (F.tid == 0) {
            __builtin_amdgcn_fence(__ATOMIC_RELEASE, "agent");
            __hip_atomic_fetch_add(F.ctl + CW_MODDONE, 1u, __ATOMIC_RELAXED, __HIP_MEMORY_SCOPE_AGENT);
        }
    }
    {
        bf16* wrt = (bf16*)(F.ws + WS_WRT);
        for (int idx = F.vcu * 512 + F.tid; idx < NEXP * (DM / 8); idx += F.G * 512) {
            const int e = idx >> 8, k8 = idx & 255; float v[8];
#pragma unroll
            for (int j = 0; j < 8; ++j) v[j] = F.w_router[(size_t)(k8 * 8 + j) * NEXP + e];
            v4u o; o.x = cvt_pk_bf16(v[0], v[1]); o.y = cvt_pk_bf16(v[2], v[3]); o.z = cvt_pk_bf16(v[4], v[5]); o.w = cvt_pk_bf16(v[6], v[7]);
            *(v4u*)(wrt + (size_t)e * DM + k8 * 8) = o;
        }
    }
    conv_matrix<2>(F, F.w_in, DM, NPROJ, F.ws + WS_WIN, 1, 1.0f);
    conv_matrix<OUT_FP8 ? 1 : 2>(F, F.w_out, DM, DM, F.ws + WS_WOUT, 1, 64.0f);
}
constexpr int CV_KG = DM / MOE_G;
constexpr int CV_ITEMS_GU = NEXP * CV_KG * 16, CV_ITEMS_DN = NEXP * CV_KG * 8;
constexpr int CV_PER_CHUNK = 16, CV_NCHUNK_GU = CV_ITEMS_GU / CV_PER_CHUNK, CV_NCHUNK_DN = CV_ITEMS_DN / CV_PER_CHUNK;
struct ConvRegs { f32x4 v[2][16 / MOE_ES]; unsigned char* d[2]; };
__device__ __forceinline__ void conv_chunk_load(Frame& F, int chunk, bool dn, ConvRegs& R) {
    constexpr int GK = 16 / MOE_ES;
#pragma unroll
    for (int i = 0; i < 2; ++i) {
        const int it = chunk * CV_PER_CHUNK + F.wave * 2 + i;
        const float* src; int N, kg, nb; unsigned char* dst;
        if (!dn) { const int per = CV_KG * 16, mq = it / per, r = it - mq * per, mat = NEXP - 1 - mq; kg = r >> 4; nb = r & 15; N = 2 * DFF;
            src = F.w_gu + (size_t)mat * DM * 2 * DFF; dst = F.ws + WS_WGU + (size_t)mat * DM * 2 * DFF * MOE_ES; }
        else { const int per = CV_KG * 8, mq = it / per, r = it - mq * per, mat = NEXP - 1 - mq; kg = r >> 3; nb = r & 7; N = DM;
            src = F.w_dn + (size_t)mat * DFF * DM; dst = F.ws + WS_WDN + (size_t)mat * DFF * DM * MOE_ES; }
        const int n0 = nb * 256 + F.lane * 4;
        const float* sp = src + (size_t)kg * GK * N + n0;
#pragma unroll
        for (int r = 0; r < GK; ++r) R.v[i][r] = __builtin_nontemporal_load((const f32x4*)(sp + (size_t)r * N));
        R.d[i] = dst + ((size_t)kg * N + n0) * 16;
    }
}
__device__ __forceinline__ void conv_chunk_finish(const Frame& F, ConvRegs& R) {
    constexpr int GK = 16 / MOE_ES; const float scale = 64.0f;
    LAS unsigned char* scr = F.lds + F.wave * 8192;
#pragma unroll
    for (int i = 0; i < 2; ++i) {
        LAS v4u* sw = (LAS v4u*)(scr + i * 4096);
#pragma unroll
        for (int j = 0; j < 4; ++j) {
            v4u o; const f32x4* v = R.v[i];
            if constexpr (MOE_ES == 2) { o.x = cvt_pk_bf16(v[0][j], v[1][j]); o.y = cvt_pk_bf16(v[2][j], v[3][j]); o.z = cvt_pk_bf16(v[4][j], v[5][j]); o.w = cvt_pk_bf16(v[6][j], v[7][j]); }
            else { o.x = pk4_fp8(v[0][j] * scale, v[1][j] * scale, v[2][j] * scale, v[3][j] * scale); o.y = pk4_fp8(v[4][j] * scale, v[5][j] * scale, v[6][j] * scale, v[7][j] * scale);
                   o.z = pk4_fp8(v[8 % GK][j] * scale, v[9 % GK][j] * scale, v[10 % GK][j] * scale, v[11 % GK][j] * scale); o.w = pk4_fp8(v[12 % GK][j] * scale, v[13 % GK][j] * scale, v[14 % GK][j] * scale, v[15 % GK][j] * scale); }
            sw[4 * F.lane + j] = o;
        }
    }
    LDS_WAIT();
#pragma unroll
    for (int i = 0; i < 2; ++i) {
        const LAS v4u* sr = (const LAS v4u*)(scr + i * 4096);
        v4u* d = (v4u*)(R.d[i] - (size_t)F.lane * 64);
#pragma unroll
        for (int j = 0; j < 4; ++j) d[64 * j + F.lane] = sr[64 * j + F.lane];
    }
    LDS_WAIT();
}
__device__ __forceinline__ int conv_pop(Frame& F, LAS int* slot, bool dn, unsigned* done_word, unsigned done_target) {
    const int nch = dn ? CV_NCHUNK_DN : CV_NCHUNK_GU;
    if (F.tid == 0) { int c = nch;
        const bool stop = done_word && __hip_atomic_load(done_word, __ATOMIC_RELAXED, __HIP_MEMORY_SCOPE_AGENT) >= done_target;
        if (!stop) c = (int)__hip_atomic_fetch_add(F.ctl + (dn ? CW_CHEAD_DN : CW_CHEAD), 1u, __ATOMIC_RELAXED, __HIP_MEMORY_SCOPE_AGENT);
        *slot = c; }
    __syncthreads();
    const int c = *slot;
    __syncthreads();
    return c;
}
__device__ __forceinline__ void conv_pull(Frame& F, LAS int* slot, bool dn, unsigned* done_word, unsigned done_target) {
    const int nch = dn ? CV_NCHUNK_DN : CV_NCHUNK_GU;
    int c = conv_pop(F, slot, dn, done_word, done_target);
    while (c < nch) {
        ConvRegs R;
        conv_chunk_load(F, c, dn, R);
        const int cn = conv_pop(F, slot, dn, done_word, done_target);
        conv_chunk_finish(F, R);
        c = cn;
    }
}
__device__ __forceinline__ void mod_wait(Frame& F) {
    if (F.tid == 0) {
        unsigned sp = 0;
        while (__hip_atomic_load(F.ctl + CW_MODDONE, __ATOMIC_RELAXED, __HIP_MEMORY_SCOPE_AGENT) < 192u) { __builtin_amdgcn_s_sleep(2); if (++sp > (1u << 22)) break; }
        __builtin_amdgcn_fence(__ATOMIC_ACQUIRE, "agent");
    }
    __syncthreads();
}
__device__ __forceinline__ void p1_row(const Frame& F, int m, const f32x4 (&v)[8]) {
    const float* mod = (const float*)(F.ws + WS_MOD);
    bf16* H = (bf16*)(F.ws + WS_H);
    const int b = m >> 12; float s = 0.f;
#pragma unroll
    for (int j = 0; j < 8; ++j) s += (v[j].x * v[j].x + v[j].y * v[j].y) + (v[j].z * v[j].z + v[j].w * v[j].w);
    const float rstd = 1.0f / sqrtf(wave_sum(s) * (1.0f / DM) + EPS);
    const f32x4* g = (const f32x4*)F.norm1_g + F.lane;
    const f32x4* sh = (const f32x4*)(mod + (size_t)b * 12288) + F.lane;
    const f32x4* scl = (const f32x4*)(mod + (size_t)b * 12288 + 2048) + F.lane;
    v2u* o = (v2u*)(H + (size_t)m * DM) + F.lane;
#pragma unroll
    for (int j = 0; j < 8; ++j) { const f32x4 r = v[j] * rstd * g[64 * j] * (scl[64 * j] + 1.0f) + sh[64 * j];
        v2u w; w.x = cvt_pk_bf16(r.x, r.y); w.y = cvt_pk_bf16(r.z, r.w); o[64 * j] = w; }
}
__device__ __forceinline__ void p1_norm1(Frame& F) {
    const int gw = F.vcu * NWAVES + F.wave, NGW = F.G * NWAVES;
    for (int m = gw; m < MTOK; m += 4 * NGW) {
        f32x4 v[4][8];
#pragma unroll
        for (int q = 0; q < 4; ++q) { const int mq = m + q * NGW;
            if (mq < MTOK) { const f32x4* xr = (const f32x4*)(F.x + (size_t)mq * DM) + F.lane;
#pragma unroll
                for (int j = 0; j < 8; ++j) v[q][j] = __builtin_nontemporal_load(xr + 64 * j); } }
#pragma unroll
        for (int q = 0; q < 4; ++q) { const int mq = m + q * NGW; if (mq < MTOK) p1_row(F, mq, v[q]); }
    }
}

struct P3Ctx { const bf16* proj; bf16* LP; int b, h, bh, zg, t, dc, dblk, e0, r, hh; float g64, dk; float rfreq[8]; };
__device__ __forceinline__ void p3_load(const Frame& F, const P3Ctx& C, int z, v4u& k1, v4u& k2, v4u& v0, v4u& v1) {
    const size_t tok = (size_t)C.b * SEQ + (size_t)z * 64; const bf16* rp = C.proj + (tok + C.t) * NPROJ + C.h * HD;
    k1 = *(const v4u*)(rp + 1024 + C.dc * 8); k2 = *(const v4u*)(rp + 1024 + 64 + C.dc * 8);
    v0 = *(const v4u*)(C.proj + (tok + (F.tid >> 4)) * NPROJ + 2048 + C.h * HD + (F.tid & 15) * 8);
    v1 = *(const v4u*)(C.proj + (tok + 32 + (F.tid >> 4)) * NPROJ + 2048 + C.h * HD + (F.tid & 15) * 8);
}
__device__ __forceinline__ void p3_step(const Frame& F, const P3Ctx& C, int j, int buf, v4u& k1, v4u& k2, v4u& v0, v4u& v1, f32x16& acc0, f32x16& acc1) {
    constexpr int PITCH = 144, BUFB = 128 * PITCH;
    const int z = C.zg * 4 + j, pos = z * 64 + C.t, t = C.t, dc = C.dc, r = C.r, hh = C.hh;
    LAS unsigned char* KT = F.lds + buf * (2 * BUFB);
    LAS unsigned char* VT = KT + BUFB;
    {
        float cc[8], ss[8];
#pragma unroll
        for (int q = 0; q < 8; ++q) { const float rv = (float)pos * C.rfreq[q]; const float fr = rv - __builtin_floorf(rv); cc[q] = __builtin_amdgcn_cosf(fr); ss[q] = __builtin_amdgcn_sinf(fr); }
        const unsigned k1w[4] = {k1.x, k1.y, k1.z, k1.w}, k2w[4] = {k2.x, k2.y, k2.z, k2.w}, v0w[4] = {v0.x, v0.y, v0.z, v0.w}, v1w[4] = {v1.x, v1.y, v1.z, v1.w};
        const float dk = C.dk;
#pragma unroll
        for (int q = 0; q < 4; ++q) {
            const float a0 = bflo(k1w[q]), a1 = bfhi(k1w[q]), b0 = bflo(k2w[q]), b1 = bfhi(k2w[q]);
            const unsigned p1 = cvt_pk_bf16((a0 * cc[2 * q] - b0 * ss[2 * q]) * dk, (a1 * cc[2 * q + 1] - b1 * ss[2 * q + 1]) * dk);
            const unsigned p2 = cvt_pk_bf16((b0 * cc[2 * q] + a0 * ss[2 * q]) * dk, (b1 * cc[2 * q + 1] + a1 * ss[2 * q + 1]) * dk);
            const int kc = (((t >> 3) ^ dc) << 4) + ((t & 7) << 1);
            *(LAS unsigned short*)(KT + (dc * 8 + 2 * q) * PITCH + kc) = (unsigned short)(p1 & 0xffffu);
            *(LAS unsigned short*)(KT + (dc * 8 + 2 * q + 1) * PITCH + kc) = (unsigned short)(p1 >> 16);
            *(LAS unsigned short*)(KT + (64 + dc * 8 + 2 * q) * PITCH + kc) = (unsigned short)(p2 & 0xffffu);
            *(LAS unsigned short*)(KT + (64 + dc * 8 + 2 * q + 1) * PITCH + kc) = (unsigned short)(p2 >> 16);
            const int ec = F.tid & 15, tv = F.tid >> 4;
            const int vc0 = (((tv >> 3) ^ (ec & 7)) << 4) + ((tv & 7) << 1), vc1 = ((((32 + tv) >> 3) ^ (ec & 7)) << 4) + ((tv & 7) << 1);
            *(LAS unsigned short*)(VT + (ec * 8 + 2 * q) * PITCH + vc0) = (unsigned short)(v0w[q] & 0xffffu);
            *(LAS unsigned short*)(VT + (ec * 8 + 2 * q + 1) * PITCH + vc0) = (unsigned short)(v0w[q] >> 16);
            *(LAS unsigned short*)(VT + (ec * 8 + 2 * q) * PITCH + vc1) = (unsigned short)(v1w[q] & 0xffffu);
            *(LAS unsigned short*)(VT + (ec * 8 + 2 * q + 1) * PITCH + vc1) = (unsigned short)(v1w[q] >> 16);
        }
    }
    if (j + 2 < 4) p3_load(F, C, z + 2, k1, k2, v0, v1);
    {
        bf16* sp0 = C.LP + (((size_t)C.bh * NCHUNK + z) * HD + (C.e0 * 32 + 4 * hh)) * HD + C.dblk * 32 + r;
        bf16* sp1 = sp0 + (size_t)32 * HD;
#pragma unroll
        for (int i = 0; i < 16; i += 2) {
            const unsigned p0 = cvt_pk_bf16(acc0[i], acc0[i + 1]), p1 = cvt_pk_bf16(acc1[i], acc1[i + 1]);
            const int e_a = (i & 3) + 8 * (i >> 2), e_b = ((i + 1) & 3) + 8 * ((i + 1) >> 2);
            sp0[(size_t)e_a * HD] = (bf16)(p0 & 0xffffu); sp0[(size_t)e_b * HD] = (bf16)(p0 >> 16);
            sp1[(size_t)e_a * HD] = (bf16)(p1 & 0xffffu); sp1[(size_t)e_b * HD] = (bf16)(p1 >> 16);
        }
    }
    __syncthreads();
#pragma unroll
    for (int i = 0; i < 16; ++i) { acc0[i] *= C.g64; acc1[i] *= C.g64; }
#pragma unroll
    for (int s = 0; s < 4; ++s) {
        const int sw = ((2 * s + hh) ^ ((r >> 3) & 3)) << 4;
        const bf16x8 af = *(const LAS bf16x8*)(KT + (C.dblk * 32 + r) * PITCH + (sw ^ ((C.dblk & 1) << 6)));
        const bf16x8 b0 = *(const LAS bf16x8*)(VT + (C.e0 * 32 + r) * PITCH + sw);
        const bf16x8 b1 = *(const LAS bf16x8*)(VT + ((C.e0 + 1) * 32 + r) * PITCH + (sw ^ 64));
        acc0 = __builtin_amdgcn_mfma_f32_32x32x16_bf16(b0, af, acc0, 0, 0, 0);
        acc1 = __builtin_amdgcn_mfma_f32_32x32x16_bf16(b1, af, acc1, 0, 0, 0);
    }
}
__device__ __forceinline__ void p3_scan_unit(Frame& F, int unit) {
    float* TT = (float*)(F.ws + WS_TT);
    P3Ctx C; C.proj = (const bf16*)(F.ws + WS_PROJ); C.LP = (bf16*)(F.ws + WS_ST);
    C.r = F.lane & 31; C.hh = F.lane >> 5; C.bh = unit >> 4; C.zg = unit & 15; C.b = C.bh >> 3; C.h = C.bh & 7;
    const float lg = lg2gamma(C.h); C.g64 = __builtin_amdgcn_exp2f(lg * 64.0f);
    C.t = F.tid >> 3; C.dc = F.tid & 7;
#pragma unroll
    for (int q = 0; q < 8; ++q) C.rfreq[q] = __builtin_amdgcn_exp2f(-(float)(C.dc * 8 + q) * (13.287712379549449f / 64.0f)) * 0.15915494309189535f;
    C.dk = __builtin_amdgcn_exp2f(lg * (float)(63 - C.t)) * 0.08838834764831845f;
    C.dblk = F.wave >> 1; C.e0 = (F.wave & 1) * 2;
    f32x16 acc0, acc1;
#pragma unroll
    for (int i = 0; i < 16; ++i) { acc0[i] = 0.f; acc1[i] = 0.f; }
    v4u ka1, ka2, va0, va1, kb1, kb2, vb0, vb1;
    p3_load(F, C, C.zg * 4, ka1, ka2, va0, va1);
    p3_load(F, C, C.zg * 4 + 1, kb1, kb2, vb0, vb1);
#pragma unroll 1
    for (int j = 0; j < 4; j += 2) {
        p3_step(F, C, j, 0, ka1, ka2, va0, va1, acc0, acc1);
        p3_step(F, C, j + 1, 1, kb1, kb2, vb0, vb1, acc0, acc1);
    }
    {
        float* tp0 = TT + (((size_t)C.bh * 16 + C.zg) * HD + (C.e0 * 32 + 4 * C.hh)) * HD + C.dblk * 32 + C.r;
        float* tp1 = tp0 + (size_t)32 * HD;
#pragma unroll
        for (int i = 0; i < 16; ++i) { const int e_i = (i & 3) + 8 * (i >> 2); tp0[(size_t)e_i * HD] = acc0[i]; tp1[(size_t)e_i * HD] = acc1[i]; }
    }
    __syncthreads();
}
__device__ __forceinline__ void p3_conv_blocks(Frame& F, int blk_lo, int blk_hi, int blk_step) {
    const bf16* proj = (const bf16*)(F.ws + WS_PROJ);
    {
        bf16* Y = (bf16*)(F.ws + WS_Y);
        const int chc = F.tid & 127, tsub = F.tid >> 7, ch0 = chc * 8;
        float w0[8], w1[8], w2[8];
#pragma unroll
        for (int q = 0; q < 8; ++q) { w0[q] = F.conv_w[ch0 + q]; w1[q] = F.conv_w[1024 + ch0 + q]; w2[q] = F.conv_w[2048 + ch0 + q]; }
        for (int blk = blk_lo; blk < blk_hi; blk += blk_step) {
            const int t0 = blk * 32 + tsub * 8;
            float p1[8], p2[8];
#pragma unroll
            for (int q = 0; q < 8; ++q) { p1[q] = 0.f; p2[q] = 0.f; }
#pragma unroll
            for (int i = -2; i < 8; ++i) {
                const int t = t0 + i; const bool valid = ((t0 & (SEQ - 1)) + i) >= 0;
                float p[8];
                if (valid) {
                    const bf16* row = proj + (size_t)t * NPROJ;
                    const v4u cg = *(const v4u*)(row + 5120 + ch0), uu = *(const v4u*)(row + 6144 + ch0);
                    const unsigned cw[4] = {cg.x, cg.y, cg.z, cg.w}, uw[4] = {uu.x, uu.y, uu.z, uu.w};
#pragma unroll
                    for (int q = 0; q < 4; ++q) { p[2 * q] = bflo(cw[q]) * bflo(uw[q]); p[2 * q + 1] = bfhi(cw[q]) * bfhi(uw[q]); }
                } else {
#pragma unroll
                    for (int q = 0; q < 8; ++q) p[q] = 0.f;
                }
                if (i >= 0) {
                    const v4u bg = *(const v4u*)(proj + (size_t)t * NPROJ + 4096 + ch0);
                    const unsigned bw[4] = {bg.x, bg.y, bg.z, bg.w}; float o[8];
#pragma unroll
                    for (int q = 0; q < 4; ++q) {
                        o[2 * q] = bflo(bw[q]) * (w0[2 * q] * p2[2 * q] + w1[2 * q] * p1[2 * q] + w2[2 * q] * p[2 * q]);
                        o[2 * q + 1] = bfhi(bw[q]) * (w0[2 * q + 1] * p2[2 * q + 1] + w1[2 * q + 1] * p1[2 * q + 1] + w2[2 * q + 1] * p[2 * q + 1]);
                    }
                    if constexpr (OUT_FP8) { v2u ov; ov.x = pk4_fp8(o[0], o[1], o[2], o[3]); ov.y = pk4_fp8(o[4], o[5], o[6], o[7]); *(v2u*)((unsigned char*)Y + (size_t)t * DM + 1024 + ch0) = ov; }
                    else { v4u ov; ov.x = cvt_pk_bf16(o[0], o[1]); ov.y = cvt_pk_bf16(o[2], o[3]); ov.z = cvt_pk_bf16(o[4], o[5]); ov.w = cvt_pk_bf16(o[6], o[7]);
                    *(v4u*)(Y + (size_t)t * DM + 1024 + ch0) = ov; }
                }
#pragma unroll
                for (int q = 0; q < 8; ++q) { p2[q] = p1[q]; p1[q] = p[q]; }
            }
        }
    }
}

__device__ __forceinline__ void p3a_scan_conv(Frame& F) {
    for (int u = F.vcu; u < 256; u += F.G) p3_scan_unit(F, u);
    p3_conv_blocks(F, F.vcu, MTOK / 32, F.G);
}
__device__ __forceinline__ void p3b_carry(Frame& F) {
    const float* TT = (const float*)(F.ws + WS_TT); bf16* CR = (bf16*)(F.ws + WS_CARRY);
    for (int idx = F.vcu * 512 + F.tid; idx < 16 * 4096; idx += F.G * 512) {
        const int bh = idx >> 12, el = (idx & 4095) * 4;
        const float g512 = __builtin_amdgcn_exp2f(lg2gamma(bh & 7) * 256.0f);
        f32x4 c = {0.f, 0.f, 0.f, 0.f};
#pragma unroll
        for (int zg = 0; zg < 15; ++zg) {
            c = c * g512 + *(const f32x4*)(TT + ((size_t)bh * 16 + zg) * (HD * HD) + el);
            v2u o; o.x = cvt_pk_bf16(c.x, c.y); o.y = cvt_pk_bf16(c.z, c.w);
            *(v2u*)(CR + ((size_t)bh * 16 + zg + 1) * (HD * HD) + el) = o;
        }
    }
}

struct P4Regs { v4u q1, q2, k1, k2, v0, v1; };
__device__ __forceinline__ void p4_load(const Frame& F, const bf16* proj, int unit, P4Regs& R) {
    const int bh = unit >> 6, z = unit & 63, b = bh >> 3, h = bh & 7;
    const size_t tok0 = (size_t)b * SEQ + z * 64;
    const int t = F.tid >> 3, dc = F.tid & 7;
    const bf16* rowp = proj + (tok0 + t) * NPROJ + h * HD;
    R.q1 = *(const v4u*)(rowp + dc * 8); R.q2 = *(const v4u*)(rowp + 64 + dc * 8);
    R.k1 = *(const v4u*)(rowp + 1024 + dc * 8); R.k2 = *(const v4u*)(rowp + 1024 + 64 + dc * 8);
    R.v0 = *(const v4u*)(proj + (tok0 + (F.tid >> 4)) * NPROJ + 2048 + h * HD + (F.tid & 15) * 8);
    R.v1 = *(const v4u*)(proj + (tok0 + 32 + (F.tid >> 4)) * NPROJ + 2048 + h * HD + (F.tid & 15) * 8);
}
__device__ __forceinline__ void p4_retention(Frame& F) {
    const bf16* proj = (const bf16*)(F.ws + WS_PROJ);
    const bf16* ST = (const bf16*)(F.ws + WS_ST);
    float rfreq[8];
#pragma unroll
    for (int q = 0; q < 8; ++q) rfreq[q] = __builtin_amdgcn_exp2f(-(float)((F.tid & 7) * 8 + q) * (13.287712379549449f / 64.0f)) * 0.15915494309189535f;
    bf16* Y = (bf16*)(F.ws + WS_Y);
    constexpr int QP = 272, VP = 144;
    LAS unsigned char* QL = F.lds;
    LAS unsigned char* KL = F.lds + 17408;
    LAS unsigned char* VT = F.lds + 34816;
    LAS float* STAT = (LAS float*)(F.lds + 53248);
    const int lane = F.lane, w = F.wave, r = lane & 31, hh = lane >> 5, rh = w >> 2, cq = w & 3;
    P4Regs R;
    if (F.vcu < 1024) p4_load(F, proj, F.vcu, R);
    for (int unit = F.vcu; unit < 1024; unit += F.G) {
        const int bh = unit >> 6, z = unit & 63, b = bh >> 3, h = bh & 7;
        const float lg = lg2gamma(h);
        const size_t tok0 = (size_t)b * SEQ + z * 64;
        bf16x8 sf[8]; v4u cf[8];
        {
            const bf16* sp = ST + (((size_t)bh * NCHUNK + z) * HD + 32 * cq + r) * HD + 8 * hh;
            const bf16* cp = (const bf16*)(F.ws + WS_CARRY) + (((size_t)bh * 16 + (z >= 4 ? (z >> 2) : 1)) * HD + 32 * cq + r) * HD + 8 * hh;
#pragma unroll
            for (int s = 0; s < 8; ++s) { sf[s] = *(const bf16x8*)(sp + 16 * s); cf[s] = *(const v4u*)(cp + 16 * s); }
        }
        {
            const int t = F.tid >> 3, dc = F.tid & 7, pos = z * 64 + t;
            float cc[8], ss[8];
#pragma unroll
            for (int q = 0; q < 8; ++q) { const float rv = (float)pos * rfreq[q]; const float fr = rv - __builtin_floorf(rv); cc[q] = __builtin_amdgcn_cosf(fr); ss[q] = __builtin_amdgcn_sinf(fr); }
            const unsigned q1w[4] = {R.q1.x, R.q1.y, R.q1.z, R.q1.w}, q2w[4] = {R.q2.x, R.q2.y, R.q2.z, R.q2.w}, k1w[4] = {R.k1.x, R.k1.y, R.k1.z, R.k1.w}, k2w[4] = {R.k2.x, R.k2.y, R.k2.z, R.k2.w};
            unsigned qap[4], qbp[4], kap[4], kbp[4];
            const float ksc = 0.08838834764831845f;
#pragma unroll
            for (int q = 0; q < 4; ++q) {
                const float a0 = bflo(q1w[q]), a1 = bfhi(q1w[q]), b0 = bflo(q2w[q]), b1 = bfhi(q2w[q]);
                qap[q] = cvt_pk_bf16(a0 * cc[2 * q] - b0 * ss[2 * q], a1 * cc[2 * q + 1] - b1 * ss[2 * q + 1]);
                qbp[q] = cvt_pk_bf16(b0 * cc[2 * q] + a0 * ss[2 * q], b1 * cc[2 * q + 1] + a1 * ss[2 * q + 1]);
                const float e0 = bflo(k1w[q]), e1 = bfhi(k1w[q]), f0 = bflo(k2w[q]), f1 = bfhi(k2w[q]);
                kap[q] = cvt_pk_bf16((e0 * cc[2 * q] - f0 * ss[2 * q]) * ksc, (e1 * cc[2 * q + 1] - f1 * ss[2 * q + 1]) * ksc);
                kbp[q] = cvt_pk_bf16((f0 * cc[2 * q] + e0 * ss[2 * q]) * ksc, (f1 * cc[2 * q + 1] + e1 * ss[2 * q + 1]) * ksc);
            }
            *(LAS v4u*)(QL + t * QP + dc * 16) = (v4u){qap[0], qap[1], qap[2], qap[3]}; *(LAS v4u*)(QL + t * QP + 128 + dc * 16) = (v4u){qbp[0], qbp[1], qbp[2], qbp[3]};
            *(LAS v4u*)(KL + t * QP + dc * 16) = (v4u){kap[0], kap[1], kap[2], kap[3]}; *(LAS v4u*)(KL + t * QP + 128 + dc * 16) = (v4u){kbp[0], kbp[1], kbp[2], kbp[3]};
            const unsigned v0w[4] = {R.v0.x, R.v0.y, R.v0.z, R.v0.w}, v1w[4] = {R.v1.x, R.v1.y, R.v1.z, R.v1.w};
            const int ec = F.tid & 15, tv = F.tid >> 4;
            const int vc0 = (((tv >> 3) ^ (ec & 7)) << 4) + ((tv & 7) << 1), vc1 = ((((32 + tv) >> 3) ^ (ec & 7)) << 4) + ((tv & 7) << 1);
#pragma unroll
            for (int q = 0; q < 4; ++q) {
                *(LAS unsigned short*)(VT + (ec * 8 + 2 * q) * VP + vc0) = (unsigned short)(v0w[q] & 0xffffu);
                *(LAS unsigned short*)(VT + (ec * 8 + 2 * q + 1) * VP + vc0) = (unsigned short)(v0w[q] >> 16);
                *(LAS unsigned short*)(VT + (ec * 8 + 2 * q) * VP + vc1) = (unsigned short)(v1w[q] & 0xffffu);
                *(LAS unsigned short*)(VT + (ec * 8 + 2 * q + 1) * VP + vc1) = (unsigned short)(v1w[q] >> 16);
            }
        }
        v4u gv[2];
#pragma unroll
        for (int i = 0; i < 2; ++i) { const int idx = F.tid + 512 * i; gv[i] = *(const v4u*)(proj + (tok0 + (idx >> 4)) * NPROJ + 3072 + h * HD + (idx & 15) * 8); }
        if (unit + F.G < 1024) p4_load(F, proj, unit + F.G, R);
        __syncthreads();
        if (z >= 4) {
            const float dec = __builtin_amdgcn_exp2f(lg * 64.0f * (float)(z & 3));
#pragma unroll
            for (int s = 0; s < 8; ++s) { const v4u cw = cf[s]; const v4u lw = __builtin_bit_cast(v4u, sf[s]); v4u o;
                o.x = cvt_pk_bf16(bflo(lw.x) + dec * bflo(cw.x), bfhi(lw.x) + dec * bfhi(cw.x)); o.y = cvt_pk_bf16(bflo(lw.y) + dec * bflo(cw.y), bfhi(lw.y) + dec * bfhi(cw.y));
                o.z = cvt_pk_bf16(bflo(lw.z) + dec * bflo(cw.z), bfhi(lw.z) + dec * bfhi(cw.z)); o.w = cvt_pk_bf16(bflo(lw.w) + dec * bflo(cw.w), bfhi(lw.w) + dec * bfhi(cw.w));
                sf[s] = __builtin_bit_cast(bf16x8, o); }
        }
        bf16x8 qf[8];
#pragma unroll
        for (int s = 0; s < 8; ++s) qf[s] = *(const LAS bf16x8*)(QL + (32 * rh + r) * QP + (16 * s + 8 * hh) * 2);
        f32x16 acc;
#pragma unroll
        for (int i = 0; i < 16; ++i) acc[i] = 0.f;
#pragma unroll
        for (int s = 0; s < 8; ++s) acc = __builtin_amdgcn_mfma_f32_32x32x16_bf16(sf[s], qf[s], acc, 0, 0, 0);
        const int qi = 32 * rh + r;
        { const float dq = __builtin_amdgcn_exp2f(lg * (float)(qi + 1));
#pragma unroll
          for (int i = 0; i < 16; ++i) acc[i] *= dq; }
#pragma unroll
        for (int kb = 0; kb < 2; ++kb) {
            f32x16 X;
#pragma unroll
            for (int i = 0; i < 16; ++i) X[i] = 0.f;
#pragma unroll
            for (int s = 0; s < 8; ++s) { const bf16x8 kf = *(const LAS bf16x8*)(KL + (32 * kb + r) * QP + (16 * s + 8 * hh) * 2);
                X = __builtin_amdgcn_mfma_f32_32x32x16_bf16(kf, qf[s], X, 0, 0, 0); }
#pragma unroll
            for (int i = 0; i < 16; ++i) { const int key = 32 * kb + (i & 3) + 8 * (i >> 2) + 4 * hh; const int dd = qi > key ? qi - key : key - qi;
                X[i] *= __builtin_amdgcn_exp2f(lg * (float)dd); }
#pragma unroll
            for (int s2 = 0; s2 < 2; ++s2) {
                v4u pw; pw.x = cvt_pk_bf16(X[8 * s2], X[8 * s2 + 1]); pw.y = cvt_pk_bf16(X[8 * s2 + 2], X[8 * s2 + 3]); pw.z = cvt_pk_bf16(X[8 * s2 + 4], X[8 * s2 + 5]); pw.w = cvt_pk_bf16(X[8 * s2 + 6], X[8 * s2 + 7]);
                const bf16x8 pf = __builtin_bit_cast(bf16x8, pw);
                const int rsw = 4 * (cq & 1) + (r >> 3);
                const LAS unsigned char* vrow = VT + (32 * cq + r) * VP + 8 * hh;
                const v2u va = *(const LAS v2u*)(vrow + (((4 * kb + 2 * s2) ^ rsw) << 4)), vb = *(const LAS v2u*)(vrow + (((4 * kb + 2 * s2 + 1) ^ rsw) << 4));
                v4u vw; vw.x = va.x; vw.y = va.y; vw.z = vb.x; vw.w = vb.y;
                acc = __builtin_amdgcn_mfma_f32_32x32x16_bf16(__builtin_bit_cast(bf16x8, vw), pf, acc, 0, 0, 0);
            }
        }
        float s1 = 0.f, s2 = 0.f;
#pragma unroll
        for (int i = 0; i < 16; ++i) { s1 += acc[i]; s2 += acc[i] * acc[i]; }
        s1 += __shfl_xor(s1, 32); s2 += __shfl_xor(s2, 32);
        if (hh == 0) { STAT[((rh * 4 + cq) * 32 + r) * 2] = s1; STAT[((rh * 4 + cq) * 32 + r) * 2 + 1] = s2; }
        __syncthreads();
        float t1 = 0.f, t2 = 0.f;
#pragma unroll
        for (int c = 0; c < 4; ++c) { t1 += STAT[((rh * 4 + c) * 32 + r) * 2]; t2 += STAT[((rh * 4 + c) * 32 + r) * 2 + 1]; }
        const float mu = t1 * (1.0f / HD), var = fmaxf(t2 * (1.0f / HD) - mu * mu, 0.f), rstd = 1.0f / sqrtf(var + EPS);
#pragma unroll
        for (int g = 0; g < 4; ++g) {
            v2u o; o.x = cvt_pk_bf16((acc[4 * g] - mu) * rstd, (acc[4 * g + 1] - mu) * rstd); o.y = cvt_pk_bf16((acc[4 * g + 2] - mu) * rstd, (acc[4 * g + 3] - mu) * rstd);
            *(LAS v2u*)(QL + qi * QP + (32 * cq + 8 * g + 4 * hh) * 2) = o;
        }
        __syncthreads();
#pragma unroll
        for (int i = 0; i < 2; ++i) {
            const int idx = F.tid + 512 * i, t = idx >> 4, ec = idx & 15;
            const v4u ov = *(const LAS v4u*)(QL + t * QP + ec * 16);
            const unsigned ow[4] = {ov.x, ov.y, ov.z, ov.w}, gw[4] = {gv[i].x, gv[i].y, gv[i].z, gv[i].w}; unsigned rw[4];
            float yy[8];
#pragma unroll
            for (int q = 0; q < 4; ++q) { const float g0 = bflo(gw[q]), g1 = bfhi(gw[q]);
                const float y0 = g0 / (1.0f + __expf(-g0)) * bflo(ow[q]), y1 = g1 / (1.0f + __expf(-g1)) * bfhi(ow[q]);
                yy[2 * q] = y0; yy[2 * q + 1] = y1; rw[q] = cvt_pk_bf16(y0, y1); }
            if constexpr (OUT_FP8) { v2u yv; yv.x = pk4_fp8(yy[0], yy[1], yy[2], yy[3]); yv.y = pk4_fp8(yy[4], yy[5], yy[6], yy[7]); *(v2u*)((unsigned char*)Y + (tok0 + t) * DM + h * HD + ec * 8) = yv; }
            else { v4u yv; yv.x = rw[0]; yv.y = rw[1]; yv.z = rw[2]; yv.w = rw[3];
            *(v4u*)(Y + (tok0 + t) * DM + h * HD + ec * 8) = yv; }
        }
        __syncthreads();
    }
}

struct P6Row { f32x4 x[8]; v2u d[8]; };
__device__ __forceinline__ void p6_load(const Frame& F, int m, P6Row& R) {
    const f32x4* xr = (const f32x4*)(F.x + (size_t)m * DM) + F.lane;
    const v2u* dr = (const v2u*)((const bf16*)(F.ws + WS_X1) + (size_t)m * DM) + F.lane;
#pragma unroll
    for (int j = 0; j < 8; ++j) { R.x[j] = __builtin_nontemporal_load(xr + 64 * j); R.d[j] = dr[64 * j]; }
}
__device__ __forceinline__ void p6_norm(const Frame& F, int m, int tl, const P6Row& R, LAS unsigned char* H2) {
    constexpr int HP = 4112;
    const float* mod = (const float*)(F.ws + WS_MOD);
    unsigned char* H2G = F.ws + WS_H; const int b = m >> 12, lane = F.lane;
    f32x4 v[8]; float s = 0.f;
#pragma unroll
    for (int j = 0; j < 8; ++j) { const v2u dw = R.d[j]; v[j] = R.x[j] + (f32x4){bflo(dw.x), bfhi(dw.x), bflo(dw.y), bfhi(dw.y)}; s += (v[j].x * v[j].x + v[j].y * v[j].y) + (v[j].z * v[j].z + v[j].w * v[j].w); }
    {
        v2u* xo = (v2u*)((bf16*)(F.ws + WS_X1) + (size_t)m * DM) + lane;
#pragma unroll
        for (int j = 0; j < 8; ++j) { v2u wv; wv.x = cvt_pk_bf16(v[j].x, v[j].y); wv.y = cvt_pk_bf16(v[j].z, v[j].w); xo[64 * j] = wv; }
    }
    const float rstd = 1.0f / sqrtf(wave_sum(s) * (1.0f / DM) + EPS);
    const f32x4* g = (const f32x4*)F.norm2_g + lane;
    const f32x4* sh = (const f32x4*)(mod + (size_t)b * 12288 + 6144) + lane;
    const f32x4* scl = (const f32x4*)(mod + (size_t)b * 12288 + 8192) + lane;
    unsigned char* grow = H2G + (size_t)m * (DM * MOE_ES);
#pragma unroll
    for (int j = 0; j < 8; ++j) { const f32x4 rr = v[j] * rstd * g[64 * j] * (scl[64 * j] + 1.0f) + sh[64 * j];
        v2u wv; wv.x = cvt_pk_bf16(rr.x, rr.y); wv.y = cvt_pk_bf16(rr.z, rr.w);
        *(LAS v2u*)(H2 + tl * HP + (64 * j + lane) * 8) = wv;
        if constexpr (MOE_FP8) *((unsigned*)grow + 64 * j + lane) = pk4_fp8(rr.x, rr.y, rr.z, rr.w);
        else *((v2u*)grow + 64 * j + lane) = wv; }
}
__device__ __forceinline__ void p6a_router(Frame& F) {
    const bf16* wrt = (const bf16*)(F.ws + WS_WRT);
    int* tke = (int*)(F.ws + WS_TKE); float* tkw = (float*)(F.ws + WS_TKW); int* hist = (int*)(F.ws + WS_HIST);
    constexpr int HP = 4112;
    LAS unsigned char* H2 = F.lds;
    LAS float* PL = (LAS float*)(F.lds + 65792);
    LAS int* HS = (LAS int*)(F.lds + 65792 + 16384);
    const int lane = F.lane, w = F.wave, fr = lane & 15, fq = lane >> 4;
    P6Row RA, RB;
    if (F.vcu < MTOK / 16) { p6_load(F, F.vcu * 16 + 2 * w, RA); p6_load(F, F.vcu * 16 + 2 * w + 1, RB); }
    for (int unit = F.vcu; unit < MTOK / 16; unit += F.G) {
        const int tok0 = unit * 16; const bool more = unit + F.G < MTOK / 16; const int ntok0 = (unit + F.G) * 16;
        if (F.tid < 32) HS[F.tid] = 0;
        p6_norm(F, tok0 + 2 * w, 2 * w, RA, H2);
        if (more) p6_load(F, ntok0 + 2 * w, RA);
        p6_norm(F, tok0 + 2 * w + 1, 2 * w + 1, RB, H2);
        if (more) p6_load(F, ntok0 + 2 * w + 1, RB);
        bf16x8 wb0[8], wb1[8];
#pragma unroll
        for (int s = 0; s < 8; ++s) { const int k0 = 256 * w + 32 * s + 8 * fq; wb0[s] = *(const bf16x8*)(wrt + (size_t)fr * DM + k0); wb1[s] = *(const bf16x8*)(wrt + (size_t)(16 + fr) * DM + k0); }
        __syncthreads();
        {
            f32x4 a0 = {0.f, 0.f, 0.f, 0.f}, a1 = {0.f, 0.f, 0.f, 0.f};
#pragma unroll
            for (int s = 0; s < 8; ++s) {
                const int k0 = 256 * w + 32 * s + 8 * fq;
                const bf16x8 af = *(const LAS bf16x8*)(H2 + fr * HP + k0 * 2);
                a0 = __builtin_amdgcn_mfma_f32_16x16x32_bf16(af, wb0[s], a0, 0, 0, 0);
                a1 = __builtin_amdgcn_mfma_f32_16x16x32_bf16(af, wb1[s], a1, 0, 0, 0);
            }
#pragma unroll
            for (int j = 0; j < 4; ++j) { PL[(w * 16 + 4 * fq + j) * 32 + fr] = a0[j]; PL[(w * 16 + 4 * fq + j) * 32 + 16 + fr] = a1[j]; }
        }
        __syncthreads();
        {
            const int tl = F.tid >> 5, e = F.tid & 31; float cur = F.b_router[e];
#pragma unroll
            for (int q = 0; q < 8; ++q) cur += PL[(q * 16 + tl) * 32 + e];
            float tv[4]; int ti[4];
#pragma unroll
            for (int k = 0; k < 4; ++k) {
                float bv = cur; int bi = e;
#pragma unroll
                for (int o = 16; o > 0; o >>= 1) { const float ov = __shfl_xor(bv, o, 32); const int oi = __shfl_xor(bi, o, 32);
                    const bool take = (ov > bv) || (ov == bv && oi < bi); bv = take ? ov : bv; bi = take ? oi : bi; }
                tv[k] = bv; ti[k] = bi; if (e == bi) cur = -__builtin_inff();
            }
            float ex[4], sum = 0.f;
#pragma unroll
            for (int k = 0; k < 4; ++k) { ex[k] = __expf(tv[k] - tv[0]); sum += ex[k]; }
            const float inv = 1.0f / sum;
            if (e < 4) {
                const int me = e == 0 ? ti[0] : e == 1 ? ti[1] : e == 2 ? ti[2] : ti[3];
                const float mw = (e == 0 ? ex[0] : e == 1 ? ex[1] : e == 2 ? ex[2] : ex[3]) * inv;
                tke[(tok0 + tl) * 4 + e] = me; tkw[(tok0 + tl) * 4 + e] = mw;
                __hip_atomic_fetch_add(HS + me, 1, __ATOMIC_RELAXED, __HIP_MEMORY_SCOPE_WORKGROUP);
            }
        }
        __syncthreads();
        if (F.tid < 32) hist[unit * 32 + F.tid] = HS[F.tid];
        __syncthreads();
    }
}
__device__ __forceinline__ void p6b_dispatch(Frame& F) {
    const int* tke = (const int*)(F.ws + WS_TKE); const float* tkw = (const float*)(F.ws + WS_TKW); const int* hist = (const int*)(F.ws + WS_HIST);
    int* dest = (int*)(F.ws + WS_DEST); float* wrow = (float*)(F.ws + WS_WROW);
    LAS int* PART = (LAS int*)F.lds;
    LAS int* OFF = PART + 512;
    LAS int* EL = OFF + 32;
    LAS int* SL = EL + 64;
    constexpr int NUNIT = MTOK / 16;
    LAS int* OFFU = SL + 128;
    LAS float* WL = (LAS float*)(OFFU + 64);
    LAS int* EL2 = (LAS int*)(WL + 128);
    const bool fast = (F.G == 256);
    if (fast && F.tid >= 128 && F.tid < 256) { const int k = (F.tid - 128) >> 6, j = F.tid & 63, un = F.vcu + k * 256;
        EL2[k * 64 + j] = tke[un * 64 + j]; WL[k * 64 + j] = tkw[un * 64 + j]; }
    { const int e = F.tid & 31, p = F.tid >> 5; int s = 0; const int u1 = F.vcu, u2 = F.vcu + 256;
      int hv[32];
#pragma unroll
      for (int i = 0; i < 32; ++i) hv[i] = hist[(32 * p + i) * 32 + e];
#pragma unroll
      for (int i = 0; i < 32; ++i) { const int u = 32 * p + i; if (u == u1) OFFU[e] = s; if (u == u2) OFFU[32 + e] = s; s += hv[i]; }
      PART[p * 32 + e] = s; }
    __syncthreads();
    if (F.vcu == 0 && F.tid < 32) { int t = 0;
#pragma unroll
        for (int p = 0; p < 16; ++p) t += PART[p * 32 + F.tid];
        F.ctl[CW_CNT + F.tid] = (unsigned)t; }
    if (F.tid < 64) {
        LAS int* tp = (LAS int*)(F.lds + LDSCTL_OFF + 448); LAS int* cn = tp + 40;
        const int e = F.tid & 31; int c = 0;
#pragma unroll
        for (int p = 0; p < 16; ++p) c += PART[p * 32 + e];
        int incl = (c + 255) >> 8;
#pragma unroll
        for (int o = 1; o < 32; o <<= 1) { const int n = __shfl_up(incl, o); if ((F.tid & 31) >= o) incl += n; }
        if (F.tid < 32) { cn[e] = c; tp[e + 1] = incl; if (e == 0) tp[0] = 0; }
    }
    for (int unit = F.vcu, k = 0; unit < NUNIT; unit += F.G, ++k) {
        if (F.tid < 32) { int s = 0; const int pg = unit >> 5;
            for (int p = 0; p < pg; ++p) s += PART[p * 32 + F.tid];
            if (fast) s += OFFU[k * 32 + F.tid];
            else for (int u = pg * 32; u < unit; ++u) s += hist[u * 32 + F.tid];
            OFF[F.tid] = s; }
        if (F.tid >= 64 && F.tid < 128) EL[F.tid - 64] = fast ? EL2[k * 64 + F.tid - 64] : tke[unit * 64 + F.tid - 64];
        __syncthreads();
        if (F.tid < 64) { const int ei = EL[F.tid]; int rank = 0;
            const unsigned long long below = (1ull << F.tid) - 1ull;
#pragma unroll 4
            for (int e = 0; e < NEXP; ++e) { const unsigned long long mk = __ballot(ei == e); if (ei == e) rank = __popcll(mk & below); }
            const int slot = OFF[ei] + rank;
            dest[(size_t)ei * CAP + slot] = unit * 64 + F.tid; wrow[(size_t)ei * CAP + slot] = fast ? WL[k * 64 + F.tid] : tkw[unit * 64 + F.tid];
            SL[F.tid * 2] = ei; SL[F.tid * 2 + 1] = slot; }
        __syncthreads();
    }
    conv_pull(F, (LAS int*)(F.lds + LDSCTL_OFF + 768), false, nullptr, 0u);
}

__device__ __forceinline__ void moe_table(Frame& F, LAS int* tp, LAS int* cn) {
    if (F.tid < 64) {
        const int e = F.tid & 31;
        const int c = (int)__hip_atomic_load(F.ctl + CW_CNT + e, __ATOMIC_RELAXED, __HIP_MEMORY_SCOPE_AGENT);
        const int tl = (c + 255) >> 8;
        int incl = tl;
#pragma unroll
        for (int o = 1; o < 32; o <<= 1) { const int n = __shfl_up(incl, o); if ((F.tid & 31) >= o) incl += n; }
        if (F.tid < 32) { cn[e] = c; tp[e + 1] = incl; if (e == 0) tp[0] = 0; }
    }
    __syncthreads();
}

struct P9Row { unsigned cw[8][4]; v2u d[8]; };
__device__ __forceinline__ void p9_load(const Frame& F, int m, P9Row& R) {
    const unsigned char* CB = F.ws + WS_CONTRIB;
    const v2u* dr = (const v2u*)((const bf16*)(F.ws + WS_X1) + (size_t)m * DM) + F.lane;
#pragma unroll
    for (int j = 0; j < 8; ++j) {
#pragma unroll
        for (int k = 0; k < 4; ++k) R.cw[j][k] = __builtin_nontemporal_load((const unsigned*)(CB + ((size_t)m * 4 + k) * DM) + 64 * j + F.lane);
        R.d[j] = __builtin_nontemporal_load(dr + 64 * j);
    }
}
__device__ __forceinline__ void p9_row(const Frame& F, int m, const P9Row& R) {
    const float* mod = (const float*)(F.ws + WS_MOD);
    const int b = m >> 12;
    const f32x4* g2 = (const f32x4*)(mod + (size_t)b * 12288 + 10240) + F.lane;
    f32x4 v[8]; float s = 0.f;
#pragma unroll
    for (int j = 0; j < 8; ++j) {
        f32x4 mo = {0.f, 0.f, 0.f, 0.f};
#pragma unroll
        for (int k = 0; k < 4; ++k) { const unsigned cw = R.cw[j][k];
            const f32x2 lo = __builtin_amdgcn_cvt_pk_f32_fp8(cw, false), hi = __builtin_amdgcn_cvt_pk_f32_fp8(cw, true);
            mo.x += lo.x; mo.y += lo.y; mo.z += hi.x; mo.w += hi.y; }
        mo = mo * 0.0625f;
        const v2u dw = R.d[j];
        v[j] = (f32x4){bflo(dw.x), bfhi(dw.x), bflo(dw.y), bfhi(dw.y)} + g2[64 * j] * mo;
        s += (v[j].x * v[j].x + v[j].y * v[j].y) + (v[j].z * v[j].z + v[j].w * v[j].w);
    }
    const float rstd = 1.0f / sqrtf(wave_sum(s) * (1.0f / DM) + EPS);
    const f32x4* fg = (const f32x4*)F.final_g + F.lane;
    f32x4* o = (f32x4*)(F.out + (size_t)m * DM) + F.lane;
#pragma unroll
    for (int j = 0; j < 8; ++j) __builtin_nontemporal_store(v[j] * rstd * fg[64 * j], o + 64 * j);
}
__device__ __forceinline__ void p9_final(Frame& F) {
    const int gw = F.vcu * NWAVES + F.wave, NGW = F.G * NWAVES;
    for (int m = gw; m < MTOK; m += 2 * NGW) {
        const int m2 = m + NGW; const bool two = m2 < MTOK;
        P9Row RA, RB;
        p9_load(F, m, RA);
        if (two) p9_load(F, m2, RB);
        p9_row(F, m, RA);
        if (two) p9_row(F, m2, RB);
    }
}

struct Args { const float* in[16]; float* out; unsigned char* ws; int ph_lo, ph_hi, li, pad; };
__global__ void __launch_bounds__(NWAVES * 64, 2) mega_fwd(Args args) {
    extern __shared__ __attribute__((aligned(16))) unsigned char lds[];
    Frame F;
    F.lds = (LAS unsigned char*)lds;
    F.tid = threadIdx.x; F.lane = F.tid & 63; F.wave = __builtin_amdgcn_readfirstlane(F.tid >> 6);
    F.G = gridDim.x; { const int bx = blockIdx.x; F.vcu = (F.G % 8 == 0) ? (bx % 8) * (F.G / 8) + bx / 8 : bx; }
    F.ws = args.ws; F.ctl = (unsigned*)(args.ws + WS_CTL); F.out = args.out;
    F.x = args.in[0]; F.c = args.in[1]; F.norm1_g = args.in[2]; F.w_mod = args.in[3]; F.b_mod = args.in[4]; F.w_in = args.in[5]; F.conv_w = args.in[6]; F.w_out = args.in[7];
    F.norm2_g = args.in[8]; F.w_router = args.in[9]; F.b_router = args.in[10]; F.w_gu = args.in[11]; F.b_gu = args.in[12]; F.w_dn = args.in[13]; F.b_dn = args.in[14]; F.final_g = args.in[15];
    volatile LAS unsigned* MISC = (volatile LAS unsigned*)(F.lds + MISC_OFF);
    for (int u = F.tid; u < (LDS_BYTES - LDSCTL_OFF) / 4; u += NWAVES * 64) ((LAS unsigned*)(F.lds + LDSCTL_OFF))[u] = 0u;
    __syncthreads();
    XcdBarrier bar; bar.bar = F.ctl + CW_BAR; bar.x = 0; bar.st = nullptr;
    if (N_LAUNCHES != PER_PHASE) bar = xcd_barrier_post(F.ctl + CW_BAR, MISC + 8);
#define GRID_BAR() do { if (N_LAUNCHES != PER_PHASE) xcd_barrier(bar); } while (0)
    const int lo = args.ph_lo, hi = args.ph_hi;
#define IN(k) (lo <= (k) && (k) < hi)
#define BOTH(k) (IN(k) && IN((k) + 1))
    LAS int* TP = (LAS int*)(F.lds + LDSCTL_OFF + 448);
    LAS int* CN = TP + 40;

    if (IN(0)) { RUN(0, p0_prologue(F)); if (BOTH(0)) mod_wait(F); }
    if (IN(1)) { RUN(1, p1_norm1(F)); if (BOTH(1)) GRID_BAR(); }
    LAS int* QSLOT = (LAS int*)(F.lds + LDSCTL_OFF + 768);
    const int xcd_ = F.vcu >> 5, jx_ = F.vcu & 31;
    if (IN(2)) {
        constexpr int NCX = NCONV2;
        const bool split = (F.G == 256);
        if (!split || jx_ >= NCX) {
            pg8::DenseOrder S; if (split) S.init(DM * 2, MTOK, NPROJ, (32 - NCX) * 8, (jx_ - NCX) * 8 + xcd_); else S.init(DM * 2, MTOK, NPROJ, F.G, (int)blockIdx.x);
            pg8::EpiProj E{0x7f7f7f7f, (bf16*)(F.ws + WS_PROJ), NPROJ};
            RUN(2, pg8::gemm_phase<pg8::EpiProj, pg8::DenseOrder, false>(F.lds, F.ws + WS_H, F.ws + WS_WIN, DM * 2, NPROJ, S, E));
            if (F.tid == 0) __hip_atomic_fetch_add(F.ctl + CW_DONE2, 1u, __ATOMIC_RELAXED, __HIP_MEMORY_SCOPE_AGENT);
        }
        if (split) conv_pull(F, QSLOT, false, F.ctl + CW_DONE2, (unsigned)((32 - NCX) * 8));
        if (BOTH(2)) GRID_BAR();
    }
    if (IN(3)) { RUN(3, p3a_scan_conv(F)); GRID_BAR(); p3b_carry(F); if (BOTH(3)) GRID_BAR(); }
    if (IN(4)) { RUN(4, p4_retention(F)); if (BOTH(4)) GRID_BAR(); }
    if (IN(5)) {
        constexpr int NCX = NCONV5;
        const bool split = (F.G == 256);
        if (!split || jx_ >= NCX) {
            constexpr int KBO = OUT_FP8 ? DM : DM * 2;
            pg8::DenseOrder S; if (split) S.init(KBO, MTOK, DM, (32 - NCX) * 8, (jx_ - NCX) * 8 + xcd_); else S.init(KBO, MTOK, DM, F.G, (int)blockIdx.x);
            pg8::EpiDelta E{OUT_FP8 ? 0x79797979 : 0x7f7f7f7f, (const float*)(F.ws + WS_MOD), (bf16*)(F.ws + WS_X1)};
            RUN(5, pg8::gemm_phase<pg8::EpiDelta, pg8::DenseOrder, OUT_FP8 != 0>(F.lds, F.ws + WS_Y, F.ws + WS_WOUT, KBO, DM, S, E));
            if (F.tid == 0) __hip_atomic_fetch_add(F.ctl + CW_DONE5, 1u, __ATOMIC_RELAXED, __HIP_MEMORY_SCOPE_AGENT);
        }
        if (split) conv_pull(F, QSLOT, false, F.ctl + CW_DONE5, (unsigned)((32 - NCX) * 8));
        if (BOTH(5)) GRID_BAR();
    }
    if (IN(6)) { RUN(6, p6a_router(F)); if (BOTH(6)) GRID_BAR(); }
    if (IN(7)) { RUN(7, p6b_dispatch(F)); if (BOTH(7)) GRID_BAR(); }
    if (IN(8)) {
        const bool split = (F.G == 256);
        if (N_LAUNCHES == PER_PHASE) moe_table(F, TP, CN);
        int NCX = NCONV8;
        { const int U = TP[NEXP] * 16, R = (U + (255 - 8 * NCONV8)) / (256 - 8 * NCONV8);
          if (R > 0) { const int gp = (((U + R - 1) / R) + 7) & ~7; NCX = 32 - gp / 8; if (NCX < NCONV8) NCX = NCONV8; if (NCX > 16) NCX = 16; } }
        if (!split || jx_ >= NCX) {
            pg8::MoeOrder S{TP, CN, 16, split ? (32 - NCX) * 8 : F.G, split ? xcd_ * (32 - NCX) + (jx_ - NCX) : F.vcu, (unsigned)(DM * 2 * DFF * MOE_ES), 1, (const int*)(F.ws + WS_DEST)};
            pg8::EpiGateUp E{0x79797979, F.b_gu, F.ws + WS_ACT};
            RUN(8, pg8::gemm_phase<pg8::EpiGateUp, pg8::MoeOrder, MOE_FP8 != 0, true>(F.lds, F.ws + WS_H, F.ws + WS_WGU, DM * MOE_ES, 2 * DFF, S, E));
        }
        conv_pull(F, QSLOT, true, nullptr, 0u);
        if (BOTH(8)) GRID_BAR();
    }
    if (IN(9)) {
        if (N_LAUNCHES == PER_PHASE) moe_table(F, TP, CN);
        pg8::MoeOrder S{TP, CN, 8, F.G, F.vcu, (unsigned)(DFF * DM * MOE_ES), 0, nullptr};
        pg8::EpiDown E{0x79797979, F.b_dn, (const int*)(F.ws + WS_DEST), (const float*)(F.ws + WS_WROW), F.ws + WS_CONTRIB};
        RUN(9, pg8::gemm_phase<pg8::EpiDown, pg8::MoeOrder, MOE_FP8 != 0>(F.lds, F.ws + WS_ACT, F.ws + WS_WDN, DFF * MOE_ES, DM, S, E));
        if (BOTH(9)) GRID_BAR();
    }
    if (IN(10)) { RUN(10, p9_final(F)); }
#undef IN
#undef BOTH
}

extern "C" void kernel_launch(void* const* d_in, const int* in_sizes, int n_in, void* d_out, int out_size, void* d_ws, size_t ws_size, hipStream_t stream) {
    static int grid = 0;
    if (grid == 0) {
        if (n_in != 16 || out_size != MTOK * DM || ws_size < WS_END) { fprintf(stderr, "kernel_launch: unexpected shapes (n_in %d out %d ws %zu)\n", n_in, out_size, ws_size); grid = -1; return; }
        int dev = 0, cus = 0, per_cu = 0;
        if (hipGetDevice(&dev) != hipSuccess || hipDeviceGetAttribute(&cus, hipDeviceAttributeMultiprocessorCount, dev) != hipSuccess) { grid = -1; return; }
        if (hipFuncSetAttribute((const void*)mega_fwd, hipFuncAttributeMaxDynamicSharedMemorySize, LDS_BYTES) != hipSuccess) { grid = -1; return; }
        if (hipOccupancyMaxActiveBlocksPerMultiprocessor(&per_cu, (const void*)mega_fwd, NWAVES * 64, LDS_BYTES) != hipSuccess || per_cu < 1)
            fprintf(stderr, "kernel_launch: occupancy query reports %d workgroups per CU\n", per_cu);
        (void)hipGetLastError();
        grid = cus;
    }
    if (grid < 0) return;
    if (hipMemsetAsync((char*)d_ws + WS_CTL, 0, CTL_ZERO_BYTES, stream) != hipSuccess) return;
    Args a{};
    for (int i = 0; i < 16; ++i) a.in[i] = (const float*)d_in[i];
    a.out = (float*)d_out; a.ws = (unsigned char*)d_ws;
    for (int li = 0; li < N_LAUNCHES; ++li) {
        a.ph_lo = (N_LAUNCHES == PER_PHASE) ? li : 0; a.ph_hi = (N_LAUNCHES == PER_PHASE) ? li + 1 : PER_PHASE; a.li = li; a.pad = 0;
        hipLaunchKernelGGL(mega_fwd, dim3(grid), dim3(NWAVES * 64), LDS_BYTES, stream, a);
        const hipError_t le = hipPeekAtLastError();
        if (le != hipSuccess) { fprintf(stderr, "kernel_launch: launch %d failed: %s\n", li, hipGetErrorName(le)); break; }
    }
}
```

```cpp
#include <hip/hip_runtime.h>
#include <cstdio>
#include <cstdint>

#ifndef MK_N_LAUNCHES
#define MK_N_LAUNCHES 1
#endif
#ifndef MOE_FP8
#define MOE_FP8 1
#endif
#ifndef NCONV2
#define NCONV2 9
#endif
#ifndef NCONV5
#define NCONV5 16
#endif
#ifndef NCONV8
#define NCONV8 4
#endif
#ifndef OUT_FP8
#define OUT_FP8 1
#endif
#ifndef PROBE_DUP
#define PROBE_DUP -1
#endif
#define RUN(k, ...) do { __VA_ARGS__; if (PROBE_DUP == (k)) { __VA_ARGS__; } } while (0)

#define GAS __attribute__((address_space(1)))
#define LAS __attribute__((address_space(3)))
typedef unsigned short bf16;
typedef unsigned v4u __attribute__((ext_vector_type(4)));
typedef unsigned v2u __attribute__((ext_vector_type(2)));
typedef float f32x4 __attribute__((ext_vector_type(4)));
typedef float f32x2 __attribute__((ext_vector_type(2)));
typedef float f32x16 __attribute__((ext_vector_type(16)));
typedef short bf16x8 __attribute__((ext_vector_type(8)));
typedef int v8i __attribute__((ext_vector_type(8)));
typedef int v4i __attribute__((ext_vector_type(4)));

constexpr int NBATCH = 2, SEQ = 4096, DM = 2048, MTOK = NBATCH * SEQ;
constexpr int DRET = 1024, NHEAD = 8, HD = 128, CHUNK = 64, NCHUNK = SEQ / CHUNK;
constexpr int NPROJ = 7168, NEXP = 32, TOPK = 4, DFF = 2048, CAP = 8192;
constexpr float EPS = 1e-6f;
constexpr int PER_PHASE = 11;
constexpr int N_LAUNCHES = MK_N_LAUNCHES;
constexpr int NWAVES = 8;
constexpr int MOE_ES = MOE_FP8 ? 1 : 2;
constexpr int MOE_G = 16 / MOE_ES;

constexpr size_t MiB = 1u << 20;
constexpr size_t WS_CTL = 0, CTL_ZERO_BYTES = 1 * MiB;
constexpr size_t WS_MOD = 2 * MiB;
constexpr size_t WS_COS = 3 * MiB, WS_SIN = 4 * MiB;
constexpr size_t WS_WRT = 5 * MiB;
constexpr size_t WS_WIN = 8 * MiB;
constexpr size_t WS_WOUT = 40 * MiB;
constexpr size_t WS_H = 64 * MiB;
constexpr size_t WS_PROJ = 96 * MiB;
constexpr size_t WS_ST = 208 * MiB;
constexpr size_t WS_Y = 240 * MiB;
constexpr size_t WS_X1 = 272 * MiB;
constexpr size_t WS_DEST = 336 * MiB, WS_WROW = 337 * MiB;
constexpr size_t WS_TKE = 338 * MiB, WS_TKW = 339 * MiB, WS_HIST = 340 * MiB;
constexpr size_t WS_CONTRIB = 344 * MiB;
constexpr size_t WS_WGU = 512 * MiB;
constexpr size_t WS_WDN = 1024 * MiB;
constexpr size_t WS_TT = 1280 * MiB;
constexpr size_t WS_CARRY = 1296 * MiB;
constexpr size_t WS_ACT = 2304 * MiB;
constexpr size_t WS_END = 3328 * MiB;
constexpr int CW_TMO = 0, CW_BAR = 4096, CW_CNT = 16384, CW_CHEAD = 16448, CW_DONE2 = 16512, CW_DONE5 = 16576, CW_CHEAD_DN = 16640, CW_DONE8 = 16704;

constexpr int RING_BYTES = 131072;
constexpr int LDSCTL_OFF = RING_BYTES, MISC_OFF = LDSCTL_OFF + 320;
constexpr int LDS_BYTES = 147456;

__device__ __forceinline__ unsigned cvt_pk_bf16(float lo, float hi) { unsigned r; asm volatile("v_cvt_pk_bf16_f32 %0, %1, %2" : "=v"(r) : "v"(lo), "v"(hi)); return r; }
__device__ __forceinline__ float bflo(unsigned w) { return __uint_as_float(w << 16); }
__device__ __forceinline__ float bfhi(unsigned w) { return __uint_as_float(w & 0xffff0000u); }
__device__ __forceinline__ float wave_sum(float v) {
#pragma unroll
    for (int o = 1; o < 64; o <<= 1) v += __shfl_xor(v, o);
    return v;
}
__device__ __forceinline__ unsigned pk4_fp8(float a, float b, float c, float d) {
    unsigned w = 0; w = __builtin_amdgcn_cvt_pk_fp8_f32(a, b, w, false); w = __builtin_amdgcn_cvt_pk_fp8_f32(c, d, w, true); return w;
}
__device__ __forceinline__ float lg2gamma(int h) {
    const float e = __builtin_amdgcn_exp2f((float)(-5 - h));
    const float s = e * (1.f + e * (0.5f + e * (0.33333334f + e * (0.25f + e * (0.2f + e * (0.16666667f + e * 0.14285715f))))));
    return -s * 1.4426950408889634f;
}
#define LDS_WAIT() asm volatile("s_waitcnt lgkmcnt(0)" ::: "memory")
#define VM_WAIT() asm volatile("s_waitcnt vmcnt(0)" ::: "memory")

#define XB_TMO      128
#define XB_XCNT(j)  (256  + 64 * (j))
#define XB_XSUB(j)  (1280 + 64 * (j))
#define XB_XGEN(j)  (2304 + 64 * (j))
#define XB_TOP      3328
#define XB_TOPGEN   3392
#define XCD_BAR_WORDS 3456
#define XB_SPIN_CAP (1u << 18)
__device__ __forceinline__ unsigned xb_ld(unsigned* p)              { return __hip_atomic_load(p, __ATOMIC_RELAXED, __HIP_MEMORY_SCOPE_AGENT); }
__device__ __forceinline__ unsigned xb_add(unsigned* p, unsigned v) { return __hip_atomic_fetch_add(p, v, __ATOMIC_RELAXED, __HIP_MEMORY_SCOPE_AGENT); }
__device__ __forceinline__ unsigned xb_xcc_id() { return (unsigned)__builtin_amdgcn_s_getreg((3 << 11) | 20) & 0xFu; }
#define XB_SPIN(cond, bar) do { unsigned _sp = 0; while (cond) { __builtin_amdgcn_s_sleep(1); \
    if ((++_sp & 255u) == 0u) { if (xb_ld(&(bar)[XB_TMO])) break; if (_sp > XB_SPIN_CAP) { atomicAdd(&(bar)[XB_TMO], 1u); break; } } } } while (0)
struct XcdBarrier { unsigned* bar; unsigned x; volatile LAS unsigned* st; };
__device__ __forceinline__ XcdBarrier xcd_barrier_post(unsigned* bar, volatile LAS unsigned* st) {
    XcdBarrier b; b.bar = bar; b.x = xb_xcc_id(); b.st = st;
    if (threadIdx.x == 0) (void)xb_add(&bar[XB_XCNT(b.x)], 1u);
    return b;
}
__device__ __forceinline__ void xcd_barrier_complete(unsigned* bar, unsigned x, unsigned& nloc, unsigned& nx) {
    const unsigned G = gridDim.x * gridDim.y * gridDim.z;
    unsigned sum, cnt, mine, sp = 0u;
    for (;;) {
        sum = 0u; cnt = 0u; mine = 0u;
#pragma unroll
        for (unsigned j = 0; j < 16; ++j) { const unsigned c = xb_ld(&bar[XB_XCNT(j)]); sum += c; cnt += (c > 0u) ? 1u : 0u; mine = (j == x) ? c : mine; }
        if (sum == G) break;
        __builtin_amdgcn_s_sleep(1);
        if ((++sp & 255u) == 0u) { if (xb_ld(&bar[XB_TMO])) break; if (sp > XB_SPIN_CAP) { atomicAdd(&bar[XB_TMO], 1u); break; } }
    }
    nloc = mine > 0u ? mine : 1u; nx = cnt > 0u ? cnt : 1u;
}
__device__ __forceinline__ void xcd_barrier(const XcdBarrier& b) {
    asm volatile("s_waitcnt vmcnt(0)" ::: "memory");
    __syncthreads();
    if (threadIdx.x == 0) {
        unsigned* bar = b.bar;
        __builtin_amdgcn_s_waitcnt(0);
        unsigned nloc = b.st[0], nx = b.st[1];
        if (nloc == 0u) { xcd_barrier_complete(bar, b.x, nloc, nx); b.st[0] = nloc; b.st[1] = nx; }
        const unsigned old = xb_add(&bar[XB_XSUB(b.x)], 1u);
        const unsigned gen = old / nloc;
        if (old + 1u == (gen + 1u) * nloc) {
            __builtin_amdgcn_fence(__ATOMIC_RELEASE, "agent");
            asm volatile("s_waitcnt vmcnt(0)" ::: "memory");
            const unsigned og = xb_add(&bar[XB_TOP], 1u);
            const unsigned tg = og / nx;
            if (og + 1u == (tg + 1u) * nx) xb_add(&bar[XB_TOPGEN], 1u);
            else XB_SPIN(xb_ld(&bar[XB_TOPGEN]) == tg, bar);
            __builtin_amdgcn_fence(__ATOMIC_ACQUIRE, "agent");
            xb_add(&bar[XB_XGEN(b.x)], 1u);
            asm volatile("s_waitcnt vmcnt(0)" ::: "memory");
        } else {
            XB_SPIN(xb_ld(&bar[XB_XGEN(b.x)]) == gen, bar);
            __builtin_amdgcn_fence(__ATOMIC_ACQUIRE, "agent");
            asm volatile("s_waitcnt vmcnt(0)" ::: "memory");
        }
    }
    __syncthreads();
}

namespace pg8 {
constexpr int BM = 256, HALF = 128, HTB = HALF * 128, STAGE_BYTES = 8 * HTB, NXCD = 8, WGM = 8;
__host__ __device__ __forceinline__ int lds_byte(int r, int c) { const int st = (r >> 4) * 2 + (c >> 5), rr = r & 15, cc = c & 31, ob = rr * 64 + cc * 2; return st * 1024 + (ob ^ (((ob >> 9) & 1) << 5)); }
__host__ __device__ __forceinline__ void stage_rc(int b, int& R, int& C) { const int st = b / 1024, sb = b % 1024, swz = sb ^ (((sb >> 9) & 1) << 5); R = (st >> 1) * 16 + swz / 64; C = (st & 1) * 32 + (swz % 64) / 2; }
__host__ __device__ __forceinline__ int perm32(int rho) { const int n = rho >> 4, i = rho & 15; return 8 * (i >> 2) + 4 * n + (i & 3); }

struct Unit { unsigned a, b0, b1; int row0, pn, e, cnt; };

struct DenseOrder {
    int KB, nM, nN, nwg, G, c; const int* rowtok = nullptr;
    __device__ void init(int KB_, int M, int N, int G_, int c_) { KB = KB_; nM = M / BM; nN = N / BM; nwg = nM * nN; G = G_; c = c_; }
    __device__ bool next(int i, Unit& u) const {
        const long L = (long)i * G + c; if (L >= nwg) return false;
        int wgid = (int)L; { const int q = nwg / NXCD, r = nwg % NXCD, xcd = wgid % NXCD, off = wgid / NXCD; wgid = (xcd < r ? xcd * (q + 1) : r * (q + 1) + (xcd - r) * q) + off; }
        const int nig = WGM * nN, gid = wgid / nig, fm = gid * WGM, gsz = (nM - fm) < WGM ? (nM - fm) : WGM;
        const int pm = fm + ((wgid % nig) % gsz), pn = (wgid % nig) / gsz;
        u.a = (unsigned)pm * BM * KB; u.b0 = (unsigned)pn * BM * 16; u.b1 = u.b0 + HALF * 16; u.row0 = pm * BM; u.pn = pn; u.e = 0; u.cnt = 0x7fffffff; return true;
    }
};

template <class Epi, class Sched, bool FP8, bool GATHER = false>
__device__ __forceinline__ void gemm_phase(LAS unsigned char* lds, const void* Abase, const void* Bbase, const int KB  , const int NB  , const Sched& S, const Epi& E) {
    const int tid = threadIdx.x, wid = __builtin_amdgcn_readfirstlane(tid >> 6), lane = tid & 63, wr = wid >> 2, wc = wid & 3, fr = lane & 15, fq = lane >> 4;
    const int nt = KB / 128;
    unsigned voffA[2], voffB[2];
#pragma unroll
    for (int i = 0; i < 2; ++i) { int R, C; stage_rc(tid * 16 + i * 8192, R, C); const int Rb = Epi::PERM ? ((R & ~31) + perm32(R & 31)) : R;
        voffA[i] = (unsigned)(R * KB + C * 2); voffB[i] = (unsigned)(((C >> 3) * NB + Rb) * 16); }
    unsigned vA[2][2] = {{0u, 0u}, {0u, 0u}};
    LAS int* TOK = (LAS int*)(lds + STAGE_BYTES + 1024);
#define PG8_GATHER_OFFS() do { _Pragma("unroll") for (int _h = 0; _h < 2; ++_h) _Pragma("unroll") for (int _i = 0; _i < 2; ++_i) { int R_, C_; stage_rc(tid * 16 + _i * 8192, R_, C_); \
        vA[_h][_i] = (unsigned)TOK[_h * HALF + R_] * (unsigned)KB + (unsigned)(C_ * 2); } } while (0)
#define PG8_FILL_TOK(un) do { if (tid < 256) { const int r_ = (un).row0 + tid; TOK[tid] = (r_ < (un).cnt) ? (S.rowtok[(size_t)(un).e * CAP + r_] >> 2) : 0; } } while (0)
    const unsigned kstepA = 128, kstepB = (unsigned)8 * NB * 16;
    const unsigned hstepA = (unsigned)HALF * KB;
    const __amdgpu_buffer_rsrc_t rA = __builtin_amdgcn_make_buffer_rsrc((void*)Abase, 0, 0xfffffff0, 0x00020000);
    const __amdgpu_buffer_rsrc_t rB = __builtin_amdgcn_make_buffer_rsrc((void*)Bbase, 0, 0xfffffff0, 0x00020000);
    const unsigned ldsw = (unsigned)wid * 1024u;
    const int aoff = lds_byte(wr * 64 + fr, fq * 8), boff = lds_byte(wc * 32 + fr, fq * 8);
#define PG8_SA(b, h) (((b) * 2 + (h)) * HTB)
#define PG8_SB(b, h) ((4 + (b) * 2 + (h)) * HTB)
#define PG8_STAGE(bufoff, rs, soff, voff) do { _Pragma("unroll") for (int _i = 0; _i < 2; ++_i) \
        __builtin_amdgcn_raw_ptr_buffer_load_lds(rs, (LAS void*)(lds + (bufoff) + ldsw + _i * 8192), 16, (int)(voff)[_i], (int)(soff), 0, 0); } while (0)
#define PG8_STAGE_A(bufoff, h, soff) do { if constexpr (GATHER) { PG8_STAGE(bufoff, rA, soff, vA[h]); } else { PG8_STAGE(bufoff, rA, (soff) + (h) * hstepA, voffA); } } while (0)
#define PG8_LD8(p) __builtin_shufflevector(*(const LAS v4i*)(p), *(const LAS v4i*)((p) + 1024), 0, 1, 2, 3, 4, 5, 6, 7)
#define PG8_LDA(dst, b, h) do { _Pragma("unroll") for (int m = 0; m < 4; ++m) dst[m] = PG8_LD8(lds + PG8_SA(b, h) + aoff + m * 2048); } while (0)
#define PG8_LDB(dst, b, h) do { _Pragma("unroll") for (int n = 0; n < 2; ++n) dst[n] = PG8_LD8(lds + PG8_SB(b, h) + boff + n * 2048); } while (0)
#define PG8_LO(v) __builtin_bit_cast(bf16x8, __builtin_shufflevector(v, v, 0, 1, 2, 3))
#define PG8_HI(v) __builtin_bit_cast(bf16x8, __builtin_shufflevector(v, v, 4, 5, 6, 7))
#define PG8_MMA(ai, bj, At, Bt) do { __builtin_amdgcn_s_setprio(1); _Pragma("unroll") for (int m = 0; m < 4; ++m) _Pragma("unroll") for (int n = 0; n < 2; ++n) { \
        if constexpr (FP8) { asm volatile("v_mfma_scale_f32_16x16x128_f8f6f4 %0, %1, %2, %0, %3, %4 op_sel_hi:[0,0,0]" : "+v"(acc[ai][bj][m][n]) : "v"(Bt[n]), "v"(At[m]), "v"(sclB), "v"(sclA)); } \
        else { acc[ai][bj][m][n] = __builtin_amdgcn_mfma_f32_16x16x32_bf16(PG8_LO(Bt[n]), PG8_LO(At[m]), acc[ai][bj][m][n], 0, 0, 0); \
               acc[ai][bj][m][n] = __builtin_amdgcn_mfma_f32_16x16x32_bf16(PG8_HI(Bt[n]), PG8_HI(At[m]), acc[ai][bj][m][n], 0, 0, 0); } } \
        __builtin_amdgcn_s_setprio(0); } while (0)
#define PG8_WAIT_V(n) asm volatile("s_waitcnt vmcnt(" #n ")" ::: "memory")
#define PG8_WAIT_L(n) asm volatile("s_waitcnt lgkmcnt(" #n ")" ::: "memory")
#define PG8_BAR __builtin_amdgcn_s_barrier()
#define PG8_SCHED __builtin_amdgcn_sched_barrier(0)
    Unit cur, nxt; int ui = 0;
    if (!S.next(0, cur)) return;
    const int sclB = E.scale_b, sclA = 0x7f7f7f7f;
    f32x4 acc[2][2][4][2];
#pragma unroll
    for (int a = 0; a < 2; ++a)
#pragma unroll
        for (int b = 0; b < 2; ++b)
#pragma unroll
            for (int m = 0; m < 4; ++m)
#pragma unroll
                for (int n = 0; n < 2; ++n) acc[a][b][m][n] = (f32x4){0.f, 0.f, 0.f, 0.f};
    v8i At[4], B0[2], B1[2];
    unsigned cA = cur.a, cB0 = cur.b0, cB1 = cur.b1;
    if constexpr (GATHER) { PG8_FILL_TOK(cur); PG8_WAIT_L(0); PG8_BAR; PG8_GATHER_OFFS(); PG8_WAIT_L(0); PG8_BAR; }
    PG8_STAGE(PG8_SB(0, 0), rB, cB0, voffB); PG8_STAGE(PG8_SB(0, 1), rB, cB1, voffB); PG8_STAGE_A(PG8_SA(0, 0), 0, cA); PG8_STAGE_A(PG8_SA(0, 1), 1, cA);
    if (wr == 1) PG8_BAR;
    PG8_WAIT_V(2); PG8_BAR;
    PG8_STAGE(PG8_SB(1, 0), rB, cB0 + kstepB, voffB); PG8_STAGE_A(PG8_SA(1, 0), 0, cA + kstepA); PG8_STAGE(PG8_SB(1, 1), rB, cB1 + kstepB, voffB);
    PG8_WAIT_V(6); PG8_BAR;
    for (;;) {
        const bool has_next = S.next(ui + 1, nxt);
        const unsigned nA = has_next ? nxt.a : cA, nB0 = has_next ? nxt.b0 : cB0, nB1 = has_next ? nxt.b1 : cB1;
        if constexpr (GATHER) { if (has_next) PG8_FILL_TOK(nxt); }
        for (int t = 0; t < nt; t += 2) {
            const bool last = (t == nt - 2);
            const unsigned a1 = cA + (unsigned)(t + 1) * kstepA;
            const unsigned a2 = last ? nA : cA + (unsigned)(t + 2) * kstepA;
            const unsigned b20 = last ? nB0 : cB0 + (unsigned)(t + 2) * kstepB, b21 = last ? nB1 : cB1 + (unsigned)(t + 2) * kstepB;
            const unsigned a3 = a2 + kstepA, b30 = b20 + kstepB, b31 = b21 + kstepB;
            PG8_LDB(B0, 0, 0); PG8_LDB(B1, 0, 1); PG8_SCHED; PG8_LDA(At, 0, 0); PG8_STAGE_A(PG8_SA(1, 1), 1, a1);
            PG8_WAIT_V(8); PG8_WAIT_L(0); PG8_BAR; PG8_MMA(0, 0, At, B0); PG8_MMA(0, 1, At, B1); PG8_BAR; PG8_SCHED;
            if constexpr (GATHER) { if (last && has_next) PG8_GATHER_OFFS(); }
            PG8_LDA(At, 0, 1); PG8_STAGE(PG8_SB(0, 0), rB, b20, voffB); PG8_STAGE(PG8_SB(0, 1), rB, b21, voffB); PG8_STAGE_A(PG8_SA(0, 0), 0, a2);
            PG8_WAIT_V(8); PG8_WAIT_L(0); PG8_BAR; PG8_MMA(1, 0, At, B0); PG8_MMA(1, 1, At, B1); PG8_BAR; PG8_SCHED;
            PG8_LDB(B0, 1, 0); PG8_LDB(B1, 1, 1); PG8_SCHED; PG8_LDA(At, 1, 0); PG8_STAGE_A(PG8_SA(0, 1), 1, a2);
            PG8_WAIT_V(8); PG8_WAIT_L(0); PG8_BAR; PG8_MMA(0, 0, At, B0); PG8_MMA(0, 1, At, B1); PG8_BAR; PG8_SCHED;
            PG8_LDA(At, 1, 1); PG8_STAGE(PG8_SB(1, 0), rB, b30, voffB); PG8_STAGE(PG8_SB(1, 1), rB, b31, voffB); PG8_STAGE_A(PG8_SA(1, 0), 0, a3);
            PG8_WAIT_V(8); PG8_WAIT_L(0); PG8_BAR; PG8_MMA(1, 0, At, B0); PG8_MMA(1, 1, At, B1); PG8_BAR; PG8_SCHED;
        }
        if constexpr (FP8) { asm volatile("s_nop 15\n\ts_nop 15"); }
        if (wr == 0) PG8_BAR;
        { int tz = threadIdx.x; asm volatile("" : "+v"(tz));
          E(acc, cur, wr, wc, tz & 15, (tz & 63) >> 4); }
        if (!has_next) break;
#pragma unroll
        for (int a = 0; a < 2; ++a)
#pragma unroll
            for (int b = 0; b < 2; ++b)
#pragma unroll
                for (int m = 0; m < 4; ++m)
#pragma unroll
                    for (int n = 0; n < 2; ++n) acc[a][b][m][n] = (f32x4){0.f, 0.f, 0.f, 0.f};
        cur = nxt; cA = nA; cB0 = nB0; cB1 = nB1; ++ui;
        if (wr == 1) PG8_BAR;
    }
    PG8_WAIT_V(0);
    PG8_BAR;
#undef PG8_SA
#undef PG8_SB
#undef PG8_STAGE
#undef PG8_LDA
#undef PG8_STAGE_A
#undef PG8_GATHER_OFFS
#undef PG8_FILL_TOK
#undef PG8_LD8
#undef PG8_LO
#undef PG8_HI
#undef PG8_LDB
#undef PG8_MMA
#undef PG8_WAIT_V
#undef PG8_WAIT_L
#undef PG8_BAR
#undef PG8_SCHED
}

struct EpiProj {
    static constexpr bool PERM = true; int scale_b;
    bf16* O; int ldc;
    __device__ __forceinline__ void operator()(const f32x4 (&acc)[2][2][4][2], const Unit& u, int wr, int wc, int fr, int fq) const {
        const int row0 = u.row0 + wr * 64 + fr, col0 = u.pn * BM + wc * 32 + 8 * fq;
#pragma unroll
        for (int ai = 0; ai < 2; ++ai)
#pragma unroll
            for (int m = 0; m < 4; ++m) { bf16* rowp = O + (size_t)(row0 + ai * HALF + m * 16) * ldc + col0;
#pragma unroll
                for (int bj = 0; bj < 2; ++bj) { const f32x4 v0 = acc[ai][bj][m][0], v1 = acc[ai][bj][m][1];
                    v4u w; w.x = cvt_pk_bf16(v0[0], v0[1]); w.y = cvt_pk_bf16(v0[2], v0[3]); w.z = cvt_pk_bf16(v1[0], v1[1]); w.w = cvt_pk_bf16(v1[2], v1[3]);
                    *(v4u*)(rowp + bj * HALF) = w; } }
    }
};
struct EpiDelta {
    static constexpr bool PERM = true; int scale_b;
    const float* mod; bf16* out;
    __device__ __forceinline__ void operator()(const f32x4 (&acc)[2][2][4][2], const Unit& u, int wr, int wc, int fr, int fq) const {
        const int row0 = u.row0 + wr * 64 + fr, col0 = u.pn * BM + wc * 32 + 8 * fq;
        const int b = u.row0 >> 12;
        const float* g = mod + (size_t)b * 12288 + 4096 + col0;
        f32x4 gv[2][2];
#pragma unroll
        for (int bj = 0; bj < 2; ++bj)
#pragma unroll
            for (int n = 0; n < 2; ++n) gv[bj][n] = *(const f32x4*)(g + bj * HALF + 4 * n);
#pragma unroll
        for (int ai = 0; ai < 2; ++ai)
#pragma unroll
            for (int m = 0; m < 4; ++m) { bf16* rowp = out + (size_t)(row0 + ai * HALF + m * 16) * DM + col0;
#pragma unroll
                for (int bj = 0; bj < 2; ++bj) { const f32x4 v0 = acc[ai][bj][m][0] * gv[bj][0], v1 = acc[ai][bj][m][1] * gv[bj][1];
                    v4u w; w.x = cvt_pk_bf16(v0[0], v0[1]); w.y = cvt_pk_bf16(v0[2], v0[3]); w.z = cvt_pk_bf16(v1[0], v1[1]); w.w = cvt_pk_bf16(v1[2], v1[3]);
                    *(v4u*)(rowp + bj * HALF) = w; } }
    }
};
struct EpiGateUp {
    static constexpr bool PERM = true; int scale_b;
    const float* bgu; unsigned char* act;
    __device__ __forceinline__ void operator()(const f32x4 (&acc)[2][2][4][2], const Unit& u, int wr, int wc, int fr, int fq) const {
        const int c8 = u.pn * HALF + wc * 32 + 8 * fq;
        const float* bb = bgu + (size_t)u.e * 4096 + c8;
        const f32x4 bg0 = *(const f32x4*)(bb), bg1 = *(const f32x4*)(bb + 4), bu0 = *(const f32x4*)(bb + 2048), bu1 = *(const f32x4*)(bb + 2052);
        asm volatile("" :: "v"(bg0), "v"(bg1), "v"(bu0), "v"(bu1));
#pragma unroll
        for (int ai = 0; ai < 2; ++ai)
#pragma unroll
            for (int m = 0; m < 4; ++m) { const int row = u.row0 + ai * HALF + wr * 64 + m * 16 + fr;
                float o[8];
#pragma unroll
                for (int n = 0; n < 2; ++n) { const f32x4 gt = acc[ai][0][m][n] + (n ? bg1 : bg0), up = acc[ai][1][m][n] + (n ? bu1 : bu0);
#pragma unroll
                    for (int j = 0; j < 4; ++j) { const float gc = fminf(gt[j], 7.0f), uc = fminf(fmaxf(up[j], -7.0f), 7.0f);
                        const float sg = __builtin_amdgcn_rcpf(1.0f + __builtin_amdgcn_exp2f(-1.702f * 1.4426950408889634f * gc));
                        o[n * 4 + j] = (uc + 1.0f) * (gc * sg); } }
                if (row < u.cnt) {
                    const size_t off = ((size_t)u.e * CAP + row) * DFF + c8;
                    if constexpr (MOE_FP8) { v2u w; w.x = pk4_fp8(o[0], o[1], o[2], o[3]); w.y = pk4_fp8(o[4], o[5], o[6], o[7]); __builtin_nontemporal_store(w, (v2u*)(act + off)); }
                    else { v4u w; w.x = cvt_pk_bf16(o[0], o[1]); w.y = cvt_pk_bf16(o[2], o[3]); w.z = cvt_pk_bf16(o[4], o[5]); w.w = cvt_pk_bf16(o[6], o[7]); *(v4u*)(act + off * 2) = w; }
                } }
    }
};
struct EpiDown {
    static constexpr bool PERM = true; int scale_b;
    const float* bdn; const int* dest; const float* wrow; unsigned char* contrib;
    __device__ __forceinline__ void operator()(const f32x4 (&acc)[2][2][4][2], const Unit& u, int wr, int wc, int fr, int fq) const {
        const int col0 = u.pn * BM + wc * 32 + 8 * fq;
        const float* bb = bdn + (size_t)u.e * DM + col0;
        f32x4 bv[2][2];
#pragma unroll
        for (int bj = 0; bj < 2; ++bj)
#pragma unroll
            for (int n = 0; n < 2; ++n) bv[bj][n] = *(const f32x4*)(bb + bj * HALF + 4 * n);
        int dd[2][4]; float ww[2][4];
#pragma unroll
        for (int ai = 0; ai < 2; ++ai)
#pragma unroll
            for (int m = 0; m < 4; ++m) { const size_t ix = (size_t)u.e * CAP + (u.row0 + ai * HALF + wr * 64 + m * 16 + fr); dd[ai][m] = dest[ix]; ww[ai][m] = wrow[ix]; }
        asm volatile("" :: "v"(bv[0][0]), "v"(bv[0][1]), "v"(bv[1][0]), "v"(bv[1][1]));
        asm volatile("" :: "v"(dd[0][0]), "v"(dd[0][1]), "v"(dd[0][2]), "v"(dd[0][3]), "v"(dd[1][0]), "v"(dd[1][1]), "v"(dd[1][2]), "v"(dd[1][3]));
        asm volatile("" :: "v"(ww[0][0]), "v"(ww[0][1]), "v"(ww[0][2]), "v"(ww[0][3]), "v"(ww[1][0]), "v"(ww[1][1]), "v"(ww[1][2]), "v"(ww[1][3]));
#pragma unroll
        for (int ai = 0; ai < 2; ++ai)
#pragma unroll
            for (int m = 0; m < 4; ++m) { const int row = u.row0 + ai * HALF + wr * 64 + m * 16 + fr;
                if (row < u.cnt) {
                    const float w = ww[ai][m] * 16.0f;
                    unsigned char* rowp = contrib + (size_t)dd[ai][m] * DM + col0;
#pragma unroll
                    for (int bj = 0; bj < 2; ++bj) { const f32x4 v0 = (acc[ai][bj][m][0] + bv[bj][0]) * w, v1 = (acc[ai][bj][m][1] + bv[bj][1]) * w;
                        v2u o; o.x = pk4_fp8(v0[0], v0[1], v0[2], v0[3]); o.y = pk4_fp8(v1[0], v1[1], v1[2], v1[3]);
                        *(v2u*)(rowp + bj * HALF) = o; } } }
    }
};
struct MoeOrder {
    const LAS int* tp; const LAS int* cn; int npn, G, c; unsigned wstride; int gateup; const int* rowtok;
    __device__ bool next(int i, Unit& u) const {
        const int L = i * G + c; const int total = tp[NEXP] * npn; if (L >= total) return false;
        int tile = L / npn, pn = L - tile * npn;
        if (npn == 16) {
            const int nfull = tp[NEXP] >> 2, sb = L >> 6;
            if (sb < nfull) { const int r = L & 63; tile = sb * 4 + ((r & 31) >> 3); pn = (r >> 5) * 8 + (r & 7); }
        }
        int e = 0;
#pragma unroll 1
        for (int s = 16; s > 0; s >>= 1) if (tp[e + s] <= tile) e += s;
        const int mt = tile - tp[e];
        u.a = gateup ? 0u : ((unsigned)e * CAP + (unsigned)mt * BM) * (unsigned)(DFF * MOE_ES);
        const unsigned wb = (unsigned)e * wstride;
        if (gateup) { u.b0 = wb + (unsigned)pn * HALF * 16; u.b1 = wb + (unsigned)(2048 + pn * HALF) * 16; }
        else { u.b0 = wb + (unsigned)pn * BM * 16; u.b1 = u.b0 + HALF * 16; }
        u.row0 = mt * BM; u.pn = pn; u.e = e; u.cnt = cn[e]; return true;
    }
};
}

struct Frame {
    LAS unsigned char* lds;
    unsigned* ctl;
    int tid, lane, wave, vcu, G;
    const float *x, *c, *norm1_g, *w_mod, *b_mod, *w_in, *conv_w, *w_out, *norm2_g, *w_router, *b_router, *w_gu, *b_gu, *w_dn, *b_dn, *final_g;
    float* out; unsigned char* ws;
};

template <int ES>
__device__ __forceinline__ void conv_item(const float* __restrict__ src, int N, unsigned char* __restrict__ dst, int kg, int nb, int lane, float scale) {
    constexpr int GK = 16 / ES;
    const int n0 = nb * 256 + lane * 4;
    const float* s = src + (size_t)kg * GK * N + n0;
    f32x4 v[GK];
#pragma unroll
    for (int r = 0; r < GK; ++r) v[r] = __builtin_nontemporal_load((const f32x4*)(s + (size_t)r * N));
    v4u* d = (v4u*)(dst + ((size_t)kg * N + n0) * 16);
#pragma unroll
    for (int j = 0; j < 4; ++j) {
        v4u o;
        if constexpr (ES == 2) { o.x = cvt_pk_bf16(v[0][j], v[1][j]); o.y = cvt_pk_bf16(v[2][j], v[3][j]); o.z = cvt_pk_bf16(v[4][j], v[5][j]); o.w = cvt_pk_bf16(v[6][j], v[7][j]); }
        else { o.x = pk4_fp8(v[0][j] * scale, v[1][j] * scale, v[2][j] * scale, v[3][j] * scale); o.y = pk4_fp8(v[4][j] * scale, v[5][j] * scale, v[6][j] * scale, v[7][j] * scale);
               o.z = pk4_fp8(v[8 % GK][j] * scale, v[9 % GK][j] * scale, v[10 % GK][j] * scale, v[11 % GK][j] * scale); o.w = pk4_fp8(v[12 % GK][j] * scale, v[13 % GK][j] * scale, v[14 % GK][j] * scale, v[15 % GK][j] * scale); }
        d[j] = o;
    }
}
template <int ES>
__device__ __forceinline__ void conv_matrix(Frame& F, const float* src, int K, int N, unsigned char* dst, int nmat, float scale) {
    constexpr int GK = 16 / ES;
    const int gw = F.vcu * NWAVES + F.wave, NGW = F.G * NWAVES;
    const int nnb = N / 256, per = (K / GK) * nnb; const long total = (long)per * nmat;
    for (long it = gw; it < total; it += NGW) {
        const int mat = (int)(it / per), r = (int)(it - (long)mat * per), kg = r / nnb, nb = r - kg * nnb;
        conv_item<ES>(src + (size_t)mat * K * N, N, dst + (size_t)mat * K * N * ES, kg, nb, F.lane, scale);
    }
}
__device__ __forceinline__ void p0_prologue(Frame& F) {
    if (F.vcu < 192) {
        LAS float* sc = (LAS float*)F.lds;
        LAS float* red = (LAS float*)(F.lds + 16384);
        const int c4 = F.tid & 15, kq = F.tid >> 4, col = F.vcu * 64 + c4 * 4;
        f32x4 wp[8];
#pragma unroll
        for (int j = 0; j < 8; ++j) wp[j] = __builtin_nontemporal_load((const f32x4*)(F.w_mod + (size_t)(kq + 32 * j) * 12288 + col));
        for (int i = F.tid; i < 4096; i += 512) { const float v = F.c[i]; sc[i] = v / (1.0f + __expf(-v)); }
        __syncthreads();
        f32x4 a0 = {0.f, 0.f, 0.f, 0.f}, a1 = {0.f, 0.f, 0.f, 0.f};
#pragma unroll
        for (int j = 0; j < 8; ++j) { a0 += wp[j] * sc[kq + 32 * j]; a1 += wp[j] * sc[2048 + kq + 32 * j]; }
#pragma unroll 8
        for (int k = kq + 256; k < DM; k += 32) { const f32x4 w = __builtin_nontemporal_load((const f32x4*)(F.w_mod + (size_t)k * 12288 + col)); a0 += w * sc[k]; a1 += w * sc[2048 + k]; }
#pragma unroll
        for (int j = 0; j < 4; ++j) { red[(kq * 2 + 0) * 64 + c4 * 4 + j] = a0[j]; red[(kq * 2 + 1) * 64 + c4 * 4 + j] = a1[j]; }
        __syncthreads();
        if (F.tid < 128) { const int b = F.tid >> 6, cc = F.tid & 63; float s = 0.f;
#pragma unroll 8
            for (int q = 0; q < 32; ++q) s += red[(q * 2 + b) * 64 + cc];
            ((float*)(F.ws + WS_MOD))[b * 12288 + F.vcu * 64 + cc] = s + F.b_mod[F.vcu * 64 + cc]; }
        __syncthreads();
    }
    {
        bf16* wrt = (bf16*)(F.ws + WS_WRT);
        for (int idx = F.vcu * 512 + F.tid; idx < NEXP * (DM / 8); idx += F.G * 512) {
            const int e = idx >> 8, k8 = idx & 255; float v[8];
#pragma unroll
            for (int j = 0; j < 8; ++j) v[j] = F.w_router[(size_t)(k8 * 8 + j) * NEXP + e];
            v4u o; o.x = cvt_pk_bf16(v[0], v[1]); o.y = cvt_pk_bf16(v[2], v[3]); o.z = cvt_pk_bf16(v[4], v[5]); o.w = cvt_pk_bf16(v[6], v[7]);
            *(v4u*)(wrt + (size_t)e * DM + k8 * 8) = o;
        }
    }
    conv_matrix<2>(F, F.w_in, DM, NPROJ, F.ws + WS_WIN, 1, 1.0f);
    conv_matrix<OUT_FP8 ? 1 : 2>(F, F.w_out, DM, DM, F.ws + WS_WOUT, 1, 64.0f);
}
constexpr int CV_KG = DM / MOE_G;
constexpr int CV_ITEMS_GU = NEXP * CV_KG * 16, CV_ITEMS_DN = NEXP * CV_KG * 8;
constexpr int CV_PER_CHUNK = 16, CV_NCHUNK_GU = CV_ITEMS_GU / CV_PER_CHUNK, CV_NCHUNK_DN = CV_ITEMS_DN / CV_PER_CHUNK;
struct ConvRegs { f32x4 v[2][16 / MOE_ES]; unsigned char* d[2]; };
__device__ __forceinline__ void conv_chunk_load(Frame& F, int chunk, bool dn, ConvRegs& R) {
    constexpr int GK = 16 / MOE_ES;
#pragma unroll
    for (int i = 0; i < 2; ++i) {
        const int it = chunk * CV_PER_CHUNK + F.wave * 2 + i;
        const float* src; int N, kg, nb; unsigned char* dst;
        if (!dn) { const int per = CV_KG * 16, mq = it / per, r = it - mq * per, mat = NEXP - 1 - mq; kg = r >> 4; nb = r & 15; N = 2 * DFF;
            src = F.w_gu + (size_t)mat * DM * 2 * DFF; dst = F.ws + WS_WGU + (size_t)mat * DM * 2 * DFF * MOE_ES; }
        else { const int per = CV_KG * 8, mq = it / per, r = it - mq * per, mat = NEXP - 1 - mq; kg = r >> 3; nb = r & 7; N = DM;
            src = F.w_dn + (size_t)mat * DFF * DM; dst = F.ws + WS_WDN + (size_t)mat * DFF * DM * MOE_ES; }
        const int n0 = nb * 256 + F.lane * 4;
        const float* sp = src + (size_t)kg * GK * N + n0;
#pragma unroll
        for (int r = 0; r < GK; ++r) R.v[i][r] = __builtin_nontemporal_load((const f32x4*)(sp + (size_t)r * N));
        R.d[i] = dst + ((size_t)kg * N + n0) * 16;
    }
}
__device__ __forceinline__ void conv_chunk_finish(const Frame& F, ConvRegs& R) {
    constexpr int GK = 16 / MOE_ES; const float scale = 64.0f;
    LAS unsigned char* scr = F.lds + F.wave * 8192;
#pragma unroll
    for (int i = 0; i < 2; ++i) {
        LAS v4u* sw = (LAS v4u*)(scr + i * 4096);
#pragma unroll
        for (int j = 0; j < 4; ++j) {
            v4u o; const f32x4* v = R.v[i];
            if constexpr (MOE_ES == 2) { o.x = cvt_pk_bf16(v[0][j], v[1][j]); o.y = cvt_pk_bf16(v[2][j], v[3][j]); o.z = cvt_pk_bf16(v[4][j], v[5][j]); o.w = cvt_pk_bf16(v[6][j], v[7][j]); }
            else { o.x = pk4_fp8(v[0][j] * scale, v[1][j] * scale, v[2][j] * scale, v[3][j] * scale); o.y = pk4_fp8(v[4][j] * scale, v[5][j] * scale, v[6][j] * scale, v[7][j] * scale);
                   o.z = pk4_fp8(v[8 % GK][j] * scale, v[9 % GK][j] * scale, v[10 % GK][j] * scale, v[11 % GK][j] * scale); o.w = pk4_fp8(v[12 % GK][j] * scale, v[13 % GK][j] * scale, v[14 % GK][j] * scale, v[15 % GK][j] * scale); }
            sw[4 * F.lane + j] = o;
        }
    }
    LDS_WAIT();
#pragma unroll
    for (int i = 0; i < 2; ++i) {
        const LAS v4u* sr = (const LAS v4u*)(scr + i * 4096);
        v4u* d = (v4u*)(R.d[i] - (size_t)F.lane * 64);
#pragma unroll
        for (int j = 0; j < 4; ++j) d[64 * j + F.lane] = sr[64 * j + F.lane];
    }
    LDS_WAIT();
}
__device__ __forceinline__ int conv_pop(Frame& F, LAS int* slot, bool dn, unsigned* done_word, unsigned done_target) {
    const int nch = dn ? CV_NCHUNK_DN : CV_NCHUNK_GU;
    if (F.tid == 0) { int c = nch;
        const bool stop = done_word && __hip_atomic_load(done_word, __ATOMIC_RELAXED, __HIP_MEMORY_SCOPE_AGENT) >= done_target;
        if (!stop) c = (int)__hip_atomic_fetch_add(F.ctl + (dn ? CW_CHEAD_DN : CW_CHEAD), 1u, __ATOMIC_RELAXED, __HIP_MEMORY_SCOPE_AGENT);
        *slot = c; }
    __syncthreads();
    const int c = *slot;
    __syncthreads();
    return c;
}
__device__ __forceinline__ void conv_pull(Frame& F, LAS int* slot, bool dn, unsigned* done_word, unsigned done_target) {
    const int nch = dn ? CV_NCHUNK_DN : CV_NCHUNK_GU;
    int c = conv_pop(F, slot, dn, done_word, done_target);
    while (c < nch) {
        ConvRegs R;
        conv_chunk_load(F, c, dn, R);
        const int cn = conv_pop(F, slot, dn, done_word, done_target);
        conv_chunk_finish(F, R);
        c = cn;
    }
}
__device__ __forceinline__ void p1_row(const Frame& F, int m, const f32x4 (&v)[8]) {
    const float* mod = (const float*)(F.ws + WS_MOD);
    bf16* H = (bf16*)(F.ws + WS_H);
    const int b = m >> 12; float s = 0.f;
#pragma unroll
    for (int j = 0; j < 8; ++j) s += (v[j].x * v[j].x + v[j].y * v[j].y) + (v[j].z * v[j].z + v[j].w * v[j].w);
    const float rstd = 1.0f / sqrtf(wave_sum(s) * (1.0f / DM) + EPS);
    const f32x4* g = (const f32x4*)F.norm1_g + F.lane;
    const f32x4* sh = (const f32x4*)(mod + (size_t)b * 12288) + F.lane;
    const f32x4* scl = (const f32x4*)(mod + (size_t)b * 12288 + 2048) + F.lane;
    v2u* o = (v2u*)(H + (size_t)m * DM) + F.lane;
#pragma unroll
    for (int j = 0; j < 8; ++j) { const f32x4 r = v[j] * rstd * g[64 * j] * (scl[64 * j] + 1.0f) + sh[64 * j];
        v2u w; w.x = cvt_pk_bf16(r.x, r.y); w.y = cvt_pk_bf16(r.z, r.w); o[64 * j] = w; }
}
__device__ __forceinline__ void p1_norm1(Frame& F) {
    const int gw = F.vcu * NWAVES + F.wave, NGW = F.G * NWAVES;
    for (int m = gw; m < MTOK; m += 4 * NGW) {
        f32x4 v[4][8];
#pragma unroll
        for (int q = 0; q < 4; ++q) { const int mq = m + q * NGW;
            if (mq < MTOK) { const f32x4* xr = (const f32x4*)(F.x + (size_t)mq * DM) + F.lane;
#pragma unroll
                for (int j = 0; j < 8; ++j) v[q][j] = __builtin_nontemporal_load(xr + 64 * j); } }
#pragma unroll
        for (int q = 0; q < 4; ++q) { const int mq = m + q * NGW; if (mq < MTOK) p1_row(F, mq, v[q]); }
    }
}

struct P3Ctx { const bf16* proj; bf16* LP; int b, h, bh, zg, t, dc, dblk, e0, r, hh; float g64, dk; float rfreq[8]; };
__device__ __forceinline__ void p3_load(const Frame& F, const P3Ctx& C, int z, v4u& k1, v4u& k2, v4u& v0, v4u& v1) {
    const size_t tok = (size_t)C.b * SEQ + (size_t)z * 64; const bf16* rp = C.proj + (tok + C.t) * NPROJ + C.h * HD;
    k1 = *(const v4u*)(rp + 1024 + C.dc * 8); k2 = *(const v4u*)(rp + 1024 + 64 + C.dc * 8);
    v0 = *(const v4u*)(C.proj + (tok + (F.tid >> 4)) * NPROJ + 2048 + C.h * HD + (F.tid & 15) * 8);
    v1 = *(const v4u*)(C.proj + (tok + 32 + (F.tid >> 4)) * NPROJ + 2048 + C.h * HD + (F.tid & 15) * 8);
}
__device__ __forceinline__ void p3_step(const Frame& F, const P3Ctx& C, int j, int buf, v4u& k1, v4u& k2, v4u& v0, v4u& v1, f32x16& acc0, f32x16& acc1) {
    constexpr int PITCH = 144, BUFB = 128 * PITCH;
    const int z = C.zg * 4 + j, pos = z * 64 + C.t, t = C.t, dc = C.dc, r = C.r, hh = C.hh;
    LAS unsigned char* KT = F.lds + buf * (2 * BUFB);
    LAS unsigned char* VT = KT + BUFB;
    {
        float cc[8], ss[8];
#pragma unroll
        for (int q = 0; q < 8; ++q) { const float rv = (float)pos * C.rfreq[q]; const float fr = rv - __builtin_floorf(rv); cc[q] = __builtin_amdgcn_cosf(fr); ss[q] = __builtin_amdgcn_sinf(fr); }
        const unsigned k1w[4] = {k1.x, k1.y, k1.z, k1.w}, k2w[4] = {k2.x, k2.y, k2.z, k2.w}, v0w[4] = {v0.x, v0.y, v0.z, v0.w}, v1w[4] = {v1.x, v1.y, v1.z, v1.w};
        const float dk = C.dk;
#pragma unroll
        for (int q = 0; q < 4; ++q) {
            const float a0 = bflo(k1w[q]), a1 = bfhi(k1w[q]), b0 = bflo(k2w[q]), b1 = bfhi(k2w[q]);
            const unsigned p1 = cvt_pk_bf16((a0 * cc[2 * q] - b0 * ss[2 * q]) * dk, (a1 * cc[2 * q + 1] - b1 * ss[2 * q + 1]) * dk);
            const unsigned p2 = cvt_pk_bf16((b0 * cc[2 * q] + a0 * ss[2 * q]) * dk, (b1 * cc[2 * q + 1] + a1 * ss[2 * q + 1]) * dk);
            const int kc = (((t >> 3) ^ dc) << 4) + ((t & 7) << 1);
            *(LAS unsigned short*)(KT + (dc * 8 + 2 * q) * PITCH + kc) = (unsigned short)(p1 & 0xffffu);
            *(LAS unsigned short*)(KT + (dc * 8 + 2 * q + 1) * PITCH + kc) = (unsigned short)(p1 >> 16);
            *(LAS unsigned short*)(KT + (64 + dc * 8 + 2 * q) * PITCH + kc) = (unsigned short)(p2 & 0xffffu);
            *(LAS unsigned short*)(KT + (64 + dc * 8 + 2 * q + 1) * PITCH + kc) = (unsigned short)(p2 >> 16);
            const int ec = F.tid & 15, tv = F.tid >> 4;
            const int vc0 = (((tv >> 3) ^ (ec & 7)) << 4) + ((tv & 7) << 1), vc1 = ((((32 + tv) >> 3) ^ (ec & 7)) << 4) + ((tv & 7) << 1);
            *(LAS unsigned short*)(VT + (ec * 8 + 2 * q) * PITCH + vc0) = (unsigned short)(v0w[q] & 0xffffu);
            *(LAS unsigned short*)(VT + (ec * 8 + 2 * q + 1) * PITCH + vc0) = (unsigned short)(v0w[q] >> 16);
            *(LAS unsigned short*)(VT + (ec * 8 + 2 * q) * PITCH + vc1) = (unsigned short)(v1w[q] & 0xffffu);
            *(LAS unsigned short*)(VT + (ec * 8 + 2 * q + 1) * PITCH + vc1) = (unsigned short)(v1w[q] >> 16);
        }
    }
    if (j + 2 < 4) p3_load(F, C, z + 2, k1, k2, v0, v1);
    {
        bf16* sp0 = C.LP + (((size_t)C.bh * NCHUNK + z) * HD + (C.e0 * 32 + 4 * hh)) * HD + C.dblk * 32 + r;
        bf16* sp1 = sp0 + (size_t)32 * HD;
#pragma unroll
        for (int i = 0; i < 16; i += 2) {
            const unsigned p0 = cvt_pk_bf16(acc0[i], acc0[i + 1]), p1 = cvt_pk_bf16(acc1[i], acc1[i + 1]);
            const int e_a = (i & 3) + 8 * (i >> 2), e_b = ((i + 1) & 3) + 8 * ((i + 1) >> 2);
            sp0[(size_t)e_a * HD] = (bf16)(p0 & 0xffffu); sp0[(size_t)e_b * HD] = (bf16)(p0 >> 16);
            sp1[(size_t)e_a * HD] = (bf16)(p1 & 0xffffu); sp1[(size_t)e_b * HD] = (bf16)(p1 >> 16);
        }
    }
    __syncthreads();
#pragma unroll
    for (int i = 0; i < 16; ++i) { acc0[i] *= C.g64; acc1[i] *= C.g64; }
#pragma unroll
    for (int s = 0; s < 4; ++s) {
        const int sw = ((2 * s + hh) ^ ((r >> 3) & 3)) << 4;
        const bf16x8 af = *(const LAS bf16x8*)(KT + (C.dblk * 32 + r) * PITCH + (sw ^ ((C.dblk & 1) << 6)));
        const bf16x8 b0 = *(const LAS bf16x8*)(VT + (C.e0 * 32 + r) * PITCH + sw);
        const bf16x8 b1 = *(const LAS bf16x8*)(VT + ((C.e0 + 1) * 32 + r) * PITCH + (sw ^ 64));
        acc0 = __builtin_amdgcn_mfma_f32_32x32x16_bf16(b0, af, acc0, 0, 0, 0);
        acc1 = __builtin_amdgcn_mfma_f32_32x32x16_bf16(b1, af, acc1, 0, 0, 0);
    }
}
__device__ __forceinline__ void p3_scan_unit(Frame& F, int unit) {
    float* TT = (float*)(F.ws + WS_TT);
    P3Ctx C; C.proj = (const bf16*)(F.ws + WS_PROJ); C.LP = (bf16*)(F.ws + WS_ST);
    C.r = F.lane & 31; C.hh = F.lane >> 5; C.bh = unit >> 4; C.zg = unit & 15; C.b = C.bh >> 3; C.h = C.bh & 7;
    const float lg = lg2gamma(C.h); C.g64 = __builtin_amdgcn_exp2f(lg * 64.0f);
    C.t = F.tid >> 3; C.dc = F.tid & 7;
#pragma unroll
    for (int q = 0; q < 8; ++q) C.rfreq[q] = __builtin_amdgcn_exp2f(-(float)(C.dc * 8 + q) * (13.287712379549449f / 64.0f)) * 0.15915494309189535f;
    C.dk = __builtin_amdgcn_exp2f(lg * (float)(63 - C.t)) * 0.08838834764831845f;
    C.dblk = F.wave >> 1; C.e0 = (F.wave & 1) * 2;
    f32x16 acc0, acc1;
#pragma unroll
    for (int i = 0; i < 16; ++i) { acc0[i] = 0.f; acc1[i] = 0.f; }
    v4u ka1, ka2, va0, va1, kb1, kb2, vb0, vb1;
    p3_load(F, C, C.zg * 4, ka1, ka2, va0, va1);
    p3_load(F, C, C.zg * 4 + 1, kb1, kb2, vb0, vb1);
#pragma unroll 1
    for (int j = 0; j < 4; j += 2) {
        p3_step(F, C, j, 0, ka1, ka2, va0, va1, acc0, acc1);
        p3_step(F, C, j + 1, 1, kb1, kb2, vb0, vb1, acc0, acc1);
    }
    {
        float* tp0 = TT + (((size_t)C.bh * 16 + C.zg) * HD + (C.e0 * 32 + 4 * C.hh)) * HD + C.dblk * 32 + C.r;
        float* tp1 = tp0 + (size_t)32 * HD;
#pragma unroll
        for (int i = 0; i < 16; ++i) { const int e_i = (i & 3) + 8 * (i >> 2); tp0[(size_t)e_i * HD] = acc0[i]; tp1[(size_t)e_i * HD] = acc1[i]; }
    }
    __syncthreads();
}
__device__ __forceinline__ void p3_conv_blocks(Frame& F, int blk_lo, int blk_hi, int blk_step) {
    const bf16* proj = (const bf16*)(F.ws + WS_PROJ);
    {
        bf16* Y = (bf16*)(F.ws + WS_Y);
        const int chc = F.tid & 127, tsub = F.tid >> 7, ch0 = chc * 8;
        float w0[8], w1[8], w2[8];
#pragma unroll
        for (int q = 0; q < 8; ++q) { w0[q] = F.conv_w[ch0 + q]; w1[q] = F.conv_w[1024 + ch0 + q]; w2[q] = F.conv_w[2048 + ch0 + q]; }
        for (int blk = blk_lo; blk < blk_hi; blk += blk_step) {
            const int t0 = blk * 32 + tsub * 8;
            float p1[8], p2[8];
#pragma unroll
            for (int q = 0; q < 8; ++q) { p1[q] = 0.f; p2[q] = 0.f; }
#pragma unroll
            for (int i = -2; i < 8; ++i) {
                const int t = t0 + i; const bool valid = ((t0 & (SEQ - 1)) + i) >= 0;
                float p[8];
                if (valid) {
                    const bf16* row = proj + (size_t)t * NPROJ;
                    const v4u cg = *(const v4u*)(row + 5120 + ch0), uu = *(const v4u*)(row + 6144 + ch0);
                    const unsigned cw[4] = {cg.x, cg.y, cg.z, cg.w}, uw[4] = {uu.x, uu.y, uu.z, uu.w};
#pragma unroll
                    for (int q = 0; q < 4; ++q) { p[2 * q] = bflo(cw[q]) * bflo(uw[q]); p[2 * q + 1] = bfhi(cw[q]) * bfhi(uw[q]); }
                } else {
#pragma unroll
                    for (int q = 0; q < 8; ++q) p[q] = 0.f;
                }
                if (i >= 0) {
                    const v4u bg = *(const v4u*)(proj + (size_t)t * NPROJ + 4096 + ch0);
                    const unsigned bw[4] = {bg.x, bg.y, bg.z, bg.w}; float o[8];
#pragma unroll
                    for (int q = 0; q < 4; ++q) {
                        o[2 * q] = bflo(bw[q]) * (w0[2 * q] * p2[2 * q] + w1[2 * q] * p1[2 * q] + w2[2 * q] * p[2 * q]);
                        o[2 * q + 1] = bfhi(bw[q]) * (w0[2 * q + 1] * p2[2 * q + 1] + w1[2 * q + 1] * p1[2 * q + 1] + w2[2 * q + 1] * p[2 * q + 1]);
                    }
                    if constexpr (OUT_FP8) { v2u ov; ov.x = pk4_fp8(o[0], o[1], o[2], o[3]); ov.y = pk4_fp8(o[4], o[5], o[6], o[7]); *(v2u*)((unsigned char*)Y + (size_t)t * DM + 1024 + ch0) = ov; }
                    else { v4u ov; ov.x = cvt_pk_bf16(o[0], o[1]); ov.y = cvt_pk_bf16(o[2], o[3]); ov.z = cvt_pk_bf16(o[4], o[5]); ov.w = cvt_pk_bf16(o[6], o[7]);
                    *(v4u*)(Y + (size_t)t * DM + 1024 + ch0) = ov; }
                }
#pragma unroll
                for (int q = 0; q < 8; ++q) { p2[q] = p1[q]; p1[q] = p[q]; }
            }
        }
    }
}

__device__ __forceinline__ void p3a_scan_conv(Frame& F) {
    for (int u = F.vcu; u < 256; u += F.G) p3_scan_unit(F, u);
    p3_conv_blocks(F, F.vcu, MTOK / 32, F.G);
}
__device__ __forceinline__ void p3b_carry(Frame& F) {
    const float* TT = (const float*)(F.ws + WS_TT); bf16* CR = (bf16*)(F.ws + WS_CARRY);
    for (int idx = F.vcu * 512 + F.tid; idx < 16 * 4096; idx += F.G * 512) {
        const int bh = idx >> 12, el = (idx & 4095) * 4;
        const float g512 = __builtin_amdgcn_exp2f(lg2gamma(bh & 7) * 256.0f);
        f32x4 c = {0.f, 0.f, 0.f, 0.f};
#pragma unroll
        for (int zg = 0; zg < 15; ++zg) {
            c = c * g512 + *(const f32x4*)(TT + ((size_t)bh * 16 + zg) * (HD * HD) + el);
            v2u o; o.x = cvt_pk_bf16(c.x, c.y); o.y = cvt_pk_bf16(c.z, c.w);
            *(v2u*)(CR + ((size_t)bh * 16 + zg + 1) * (HD * HD) + el) = o;
        }
    }
}

struct P4Regs { v4u q1, q2, k1, k2, v0, v1; };
__device__ __forceinline__ void p4_load(const Frame& F, const bf16* proj, int unit, P4Regs& R) {
    const int bh = unit >> 6, z = unit & 63, b = bh >> 3, h = bh & 7;
    const size_t tok0 = (size_t)b * SEQ + z * 64;
    const int t = F.tid >> 3, dc = F.tid & 7;
    const bf16* rowp = proj + (tok0 + t) * NPROJ + h * HD;
    R.q1 = *(const v4u*)(rowp + dc * 8); R.q2 = *(const v4u*)(rowp + 64 + dc * 8);
    R.k1 = *(const v4u*)(rowp + 1024 + dc * 8); R.k2 = *(const v4u*)(rowp + 1024 + 64 + dc * 8);
    R.v0 = *(const v4u*)(proj + (tok0 + (F.tid >> 4)) * NPROJ + 2048 + h * HD + (F.tid & 15) * 8);
    R.v1 = *(const v4u*)(proj + (tok0 + 32 + (F.tid >> 4)) * NPROJ + 2048 + h * HD + (F.tid & 15) * 8);
}
__device__ __forceinline__ void p4_retention(Frame& F) {
    const bf16* proj = (const bf16*)(F.ws + WS_PROJ);
    const bf16* ST = (const bf16*)(F.ws + WS_ST);
    float rfreq[8];
#pragma unroll
    for (int q = 0; q < 8; ++q) rfreq[q] = __builtin_amdgcn_exp2f(-(float)((F.tid & 7) * 8 + q) * (13.287712379549449f / 64.0f)) * 0.15915494309189535f;
    bf16* Y = (bf16*)(F.ws + WS_Y);
    constexpr int QP = 272, VP = 144;
    LAS unsigned char* QL = F.lds;
    LAS unsigned char* KL = F.lds + 17408;
    LAS unsigned char* VT = F.lds + 34816;
    LAS float* STAT = (LAS float*)(F.lds + 53248);
    const int lane = F.lane, w = F.wave, r = lane & 31, hh = lane >> 5, rh = w >> 2, cq = w & 3;
    P4Regs R;
    if (F.vcu < 1024) p4_load(F, proj, F.vcu, R);
    for (int unit = F.vcu; unit < 1024; unit += F.G) {
        const int bh = unit >> 6, z = unit & 63, b = bh >> 3, h = bh & 7;
        const float lg = lg2gamma(h);
        const size_t tok0 = (size_t)b * SEQ + z * 64;
        bf16x8 sf[8]; v4u cf[8];
        {
            const bf16* sp = ST + (((size_t)bh * NCHUNK + z) * HD + 32 * cq + r) * HD + 8 * hh;
            const bf16* cp = (const bf16*)(F.ws + WS_CARRY) + (((size_t)bh * 16 + (z >= 4 ? (z >> 2) : 1)) * HD + 32 * cq + r) * HD + 8 * hh;
#pragma unroll
            for (int s = 0; s < 8; ++s) { sf[s] = *(const bf16x8*)(sp + 16 * s); cf[s] = *(const v4u*)(cp + 16 * s); }
        }
        {
            const int t = F.tid >> 3, dc = F.tid & 7, pos = z * 64 + t;
            float cc[8], ss[8];
#pragma unroll
            for (int q = 0; q < 8; ++q) { const float rv = (float)pos * rfreq[q]; const float fr = rv - __builtin_floorf(rv); cc[q] = __builtin_amdgcn_cosf(fr); ss[q] = __builtin_amdgcn_sinf(fr); }
            const unsigned q1w[4] = {R.q1.x, R.q1.y, R.q1.z, R.q1.w}, q2w[4] = {R.q2.x, R.q2.y, R.q2.z, R.q2.w}, k1w[4] = {R.k1.x, R.k1.y, R.k1.z, R.k1.w}, k2w[4] = {R.k2.x, R.k2.y, R.k2.z, R.k2.w};
            unsigned qap[4], qbp[4], kap[4], kbp[4];
            const float ksc = 0.08838834764831845f;
#pragma unroll
            for (int q = 0; q < 4; ++q) {
                const float a0 = bflo(q1w[q]), a1 = bfhi(q1w[q]), b0 = bflo(q2w[q]), b1 = bfhi(q2w[q]);
                qap[q] = cvt_pk_bf16(a0 * cc[2 * q] - b0 * ss[2 * q], a1 * cc[2 * q + 1] - b1 * ss[2 * q + 1]);
                qbp[q] = cvt_pk_bf16(b0 * cc[2 * q] + a0 * ss[2 * q], b1 * cc[2 * q + 1] + a1 * ss[2 * q + 1]);
                const float e0 = bflo(k1w[q]), e1 = bfhi(k1w[q]), f0 = bflo(k2w[q]), f1 = bfhi(k2w[q]);
                kap[q] = cvt_pk_bf16((e0 * cc[2 * q] - f0 * ss[2 * q]) * ksc, (e1 * cc[2 * q + 1] - f1 * ss[2 * q + 1]) * ksc);
                kbp[q] = cvt_pk_bf16((f0 * cc[2 * q] + e0 * ss[2 * q]) * ksc, (f1 * cc[2 * q + 1] + e1 * ss[2 * q + 1]) * ksc);
            }
            *(LAS v4u*)(QL + t * QP + dc * 16) = (v4u){qap[0], qap[1], qap[2], qap[3]}; *(LAS v4u*)(QL + t * QP + 128 + dc * 16) = (v4u){qbp[0], qbp[1], qbp[2], qbp[3]};
            *(LAS v4u*)(KL + t * QP + dc * 16) = (v4u){kap[0], kap[1], kap[2], kap[3]}; *(LAS v4u*)(KL + t * QP + 128 + dc * 16) = (v4u){kbp[0], kbp[1], kbp[2], kbp[3]};
            const unsigned v0w[4] = {R.v0.x, R.v0.y, R.v0.z, R.v0.w}, v1w[4] = {R.v1.x, R.v1.y, R.v1.z, R.v1.w};
            const int ec = F.tid & 15, tv = F.tid >> 4;
            const int vc0 = (((tv >> 3) ^ (ec & 7)) << 4) + ((tv & 7) << 1), vc1 = ((((32 + tv) >> 3) ^ (ec & 7)) << 4) + ((tv & 7) << 1);
#pragma unroll
            for (int q = 0; q < 4; ++q) {
                *(LAS unsigned short*)(VT + (ec * 8 + 2 * q) * VP + vc0) = (unsigned short)(v0w[q] & 0xffffu);
                *(LAS unsigned short*)(VT + (ec * 8 + 2 * q + 1) * VP + vc0) = (unsigned short)(v0w[q] >> 16);
                *(LAS unsigned short*)(VT + (ec * 8 + 2 * q) * VP + vc1) = (unsigned short)(v1w[q] & 0xffffu);
                *(LAS unsigned short*)(VT + (ec * 8 + 2 * q + 1) * VP + vc1) = (unsigned short)(v1w[q] >> 16);
            }
        }
        v4u gv[2];
#pragma unroll
        for (int i = 0; i < 2; ++i) { const int idx = F.tid + 512 * i; gv[i] = *(const v4u*)(proj + (tok0 + (idx >> 4)) * NPROJ + 3072 + h * HD + (idx & 15) * 8); }
        if (unit + F.G < 1024) p4_load(F, proj, unit + F.G, R);
        __syncthreads();
        if (z >= 4) {
            const float dec = __builtin_amdgcn_exp2f(lg * 64.0f * (float)(z & 3));
#pragma unroll
            for (int s = 0; s < 8; ++s) { const v4u cw = cf[s]; const v4u lw = __builtin_bit_cast(v4u, sf[s]); v4u o;
                o.x = cvt_pk_bf16(bflo(lw.x) + dec * bflo(cw.x), bfhi(lw.x) + dec * bfhi(cw.x)); o.y = cvt_pk_bf16(bflo(lw.y) + dec * bflo(cw.y), bfhi(lw.y) + dec * bfhi(cw.y));
                o.z = cvt_pk_bf16(bflo(lw.z) + dec * bflo(cw.z), bfhi(lw.z) + dec * bfhi(cw.z)); o.w = cvt_pk_bf16(bflo(lw.w) + dec * bflo(cw.w), bfhi(lw.w) + dec * bfhi(cw.w));
                sf[s] = __builtin_bit_cast(bf16x8, o); }
        }
        bf16x8 qf[8];
#pragma unroll
        for (int s = 0; s < 8; ++s) qf[s] = *(const LAS bf16x8*)(QL + (32 * rh + r) * QP + (16 * s + 8 * hh) * 2);
        f32x16 acc;
#pragma unroll
        for (int i = 0; i < 16; ++i) acc[i] = 0.f;
#pragma unroll
        for (int s = 0; s < 8; ++s) acc = __builtin_amdgcn_mfma_f32_32x32x16_bf16(sf[s], qf[s], acc, 0, 0, 0);
        const int qi = 32 * rh + r;
        { const float dq = __builtin_amdgcn_exp2f(lg * (float)(qi + 1));
#pragma unroll
          for (int i = 0; i < 16; ++i) acc[i] *= dq; }
#pragma unroll
        for (int kb = 0; kb < 2; ++kb) {
            f32x16 X;
#pragma unroll
            for (int i = 0; i < 16; ++i) X[i] = 0.f;
#pragma unroll
            for (int s = 0; s < 8; ++s) { const bf16x8 kf = *(const LAS bf16x8*)(KL + (32 * kb + r) * QP + (16 * s + 8 * hh) * 2);
                X = __builtin_amdgcn_mfma_f32_32x32x16_bf16(kf, qf[s], X, 0, 0, 0); }
#pragma unroll
            for (int i = 0; i < 16; ++i) { const int key = 32 * kb + (i & 3) + 8 * (i >> 2) + 4 * hh; const int dd = qi > key ? qi - key : key - qi;
                X[i] *= __builtin_amdgcn_exp2f(lg * (float)dd); }
#pragma unroll
            for (int s2 = 0; s2 < 2; ++s2) {
                v4u pw; pw.x = cvt_pk_bf16(X[8 * s2], X[8 * s2 + 1]); pw.y = cvt_pk_bf16(X[8 * s2 + 2], X[8 * s2 + 3]); pw.z = cvt_pk_bf16(X[8 * s2 + 4], X[8 * s2 + 5]); pw.w = cvt_pk_bf16(X[8 * s2 + 6], X[8 * s2 + 7]);
                const bf16x8 pf = __builtin_bit_cast(bf16x8, pw);
                const int rsw = 4 * (cq & 1) + (r >> 3);
                const LAS unsigned char* vrow = VT + (32 * cq + r) * VP + 8 * hh;
                const v2u va = *(const LAS v2u*)(vrow + (((4 * kb + 2 * s2) ^ rsw) << 4)), vb = *(const LAS v2u*)(vrow + (((4 * kb + 2 * s2 + 1) ^ rsw) << 4));
                v4u vw; vw.x = va.x; vw.y = va.y; vw.z = vb.x; vw.w = vb.y;
                acc = __builtin_amdgcn_mfma_f32_32x32x16_bf16(__builtin_bit_cast(bf16x8, vw), pf, acc, 0, 0, 0);
            }
        }
        float s1 = 0.f, s2 = 0.f;
#pragma unroll
        for (int i = 0; i < 16; ++i) { s1 += acc[i]; s2 += acc[i] * acc[i]; }
        s1 += __shfl_xor(s1, 32); s2 += __shfl_xor(s2, 32);
        if (hh == 0) { STAT[((rh * 4 + cq) * 32 + r) * 2] = s1; STAT[((rh * 4 + cq) * 32 + r) * 2 + 1] = s2; }
        __syncthreads();
        float t1 = 0.f, t2 = 0.f;
#pragma unroll
        for (int c = 0; c < 4; ++c) { t1 += STAT[((rh * 4 + c) * 32 + r) * 2]; t2 += STAT[((rh * 4 + c) * 32 + r) * 2 + 1]; }
        const float mu = t1 * (1.0f / HD), var = fmaxf(t2 * (1.0f / HD) - mu * mu, 0.f), rstd = 1.0f / sqrtf(var + EPS);
#pragma unroll
        for (int g = 0; g < 4; ++g) {
            v2u o; o.x = cvt_pk_bf16((acc[4 * g] - mu) * rstd, (acc[4 * g + 1] - mu) * rstd); o.y = cvt_pk_bf16((acc[4 * g + 2] - mu) * rstd, (acc[4 * g + 3] - mu) * rstd);
            *(LAS v2u*)(QL + qi * QP + (32 * cq + 8 * g + 4 * hh) * 2) = o;
        }
        __syncthreads();
#pragma unroll
        for (int i = 0; i < 2; ++i) {
            const int idx = F.tid + 512 * i, t = idx >> 4, ec = idx & 15;
            const v4u ov = *(const LAS v4u*)(QL + t * QP + ec * 16);
            const unsigned ow[4] = {ov.x, ov.y, ov.z, ov.w}, gw[4] = {gv[i].x, gv[i].y, gv[i].z, gv[i].w}; unsigned rw[4];
            float yy[8];
#pragma unroll
            for (int q = 0; q < 4; ++q) { const float g0 = bflo(gw[q]), g1 = bfhi(gw[q]);
                const float y0 = g0 / (1.0f + __expf(-g0)) * bflo(ow[q]), y1 = g1 / (1.0f + __expf(-g1)) * bfhi(ow[q]);
                yy[2 * q] = y0; yy[2 * q + 1] = y1; rw[q] = cvt_pk_bf16(y0, y1); }
            if constexpr (OUT_FP8) { v2u yv; yv.x = pk4_fp8(yy[0], yy[1], yy[2], yy[3]); yv.y = pk4_fp8(yy[4], yy[5], yy[6], yy[7]); *(v2u*)((unsigned char*)Y + (tok0 + t) * DM + h * HD + ec * 8) = yv; }
            else { v4u yv; yv.x = rw[0]; yv.y = rw[1]; yv.z = rw[2]; yv.w = rw[3];
            *(v4u*)(Y + (tok0 + t) * DM + h * HD + ec * 8) = yv; }
        }
        __syncthreads();
    }
}

struct P6Row { f32x4 x[8]; v2u d[8]; };
__device__ __forceinline__ void p6_load(const Frame& F, int m, P6Row& R) {
    const f32x4* xr = (const f32x4*)(F.x + (size_t)m * DM) + F.lane;
    const v2u* dr = (const v2u*)((const bf16*)(F.ws + WS_X1) + (size_t)m * DM) + F.lane;
#pragma unroll
    for (int j = 0; j < 8; ++j) { R.x[j] = __builtin_nontemporal_load(xr + 64 * j); R.d[j] = dr[64 * j]; }
}
__device__ __forceinline__ void p6_norm(const Frame& F, int m, int tl, const P6Row& R, LAS unsigned char* H2) {
    constexpr int HP = 4112;
    const float* mod = (const float*)(F.ws + WS_MOD);
    unsigned char* H2G = F.ws + WS_H; const int b = m >> 12, lane = F.lane;
    f32x4 v[8]; float s = 0.f;
#pragma unroll
    for (int j = 0; j < 8; ++j) { const v2u dw = R.d[j]; v[j] = R.x[j] + (f32x4){bflo(dw.x), bfhi(dw.x), bflo(dw.y), bfhi(dw.y)}; s += (v[j].x * v[j].x + v[j].y * v[j].y) + (v[j].z * v[j].z + v[j].w * v[j].w); }
    {
        v2u* xo = (v2u*)((bf16*)(F.ws + WS_X1) + (size_t)m * DM) + lane;
#pragma unroll
        for (int j = 0; j < 8; ++j) { v2u wv; wv.x = cvt_pk_bf16(v[j].x, v[j].y); wv.y = cvt_pk_bf16(v[j].z, v[j].w); xo[64 * j] = wv; }
    }
    const float rstd = 1.0f / sqrtf(wave_sum(s) * (1.0f / DM) + EPS);
    const f32x4* g = (const f32x4*)F.norm2_g + lane;
    const f32x4* sh = (const f32x4*)(mod + (size_t)b * 12288 + 6144) + lane;
    const f32x4* scl = (const f32x4*)(mod + (size_t)b * 12288 + 8192) + lane;
    unsigned char* grow = H2G + (size_t)m * (DM * MOE_ES);
#pragma unroll
    for (int j = 0; j < 8; ++j) { const f32x4 rr = v[j] * rstd * g[64 * j] * (scl[64 * j] + 1.0f) + sh[64 * j];
        v2u wv; wv.x = cvt_pk_bf16(rr.x, rr.y); wv.y = cvt_pk_bf16(rr.z, rr.w);
        *(LAS v2u*)(H2 + tl * HP + (64 * j + lane) * 8) = wv;
        if constexpr (MOE_FP8) *((unsigned*)grow + 64 * j + lane) = pk4_fp8(rr.x, rr.y, rr.z, rr.w);
        else *((v2u*)grow + 64 * j + lane) = wv; }
}
__device__ __forceinline__ void p6a_router(Frame& F) {
    const bf16* wrt = (const bf16*)(F.ws + WS_WRT);
    int* tke = (int*)(F.ws + WS_TKE); float* tkw = (float*)(F.ws + WS_TKW); int* hist = (int*)(F.ws + WS_HIST);
    constexpr int HP = 4112;
    LAS unsigned char* H2 = F.lds;
    LAS float* PL = (LAS float*)(F.lds + 65792);
    LAS int* HS = (LAS int*)(F.lds + 65792 + 16384);
    const int lane = F.lane, w = F.wave, fr = lane & 15, fq = lane >> 4;
    P6Row RA, RB;
    if (F.vcu < MTOK / 16) { p6_load(F, F.vcu * 16 + 2 * w, RA); p6_load(F, F.vcu * 16 + 2 * w + 1, RB); }
    for (int unit = F.vcu; unit < MTOK / 16; unit += F.G) {
        const int tok0 = unit * 16; const bool more = unit + F.G < MTOK / 16; const int ntok0 = (unit + F.G) * 16;
        if (F.tid < 32) HS[F.tid] = 0;
        p6_norm(F, tok0 + 2 * w, 2 * w, RA, H2);
        if (more) p6_load(F, ntok0 + 2 * w, RA);
        p6_norm(F, tok0 + 2 * w + 1, 2 * w + 1, RB, H2);
        if (more) p6_load(F, ntok0 + 2 * w + 1, RB);
        bf16x8 wb0[8], wb1[8];
#pragma unroll
        for (int s = 0; s < 8; ++s) { const int k0 = 256 * w + 32 * s + 8 * fq; wb0[s] = *(const bf16x8*)(wrt + (size_t)fr * DM + k0); wb1[s] = *(const bf16x8*)(wrt + (size_t)(16 + fr) * DM + k0); }
        __syncthreads();
        {
            f32x4 a0 = {0.f, 0.f, 0.f, 0.f}, a1 = {0.f, 0.f, 0.f, 0.f};
#pragma unroll
            for (int s = 0; s < 8; ++s) {
                const int k0 = 256 * w + 32 * s + 8 * fq;
                const bf16x8 af = *(const LAS bf16x8*)(H2 + fr * HP + k0 * 2);
                a0 = __builtin_amdgcn_mfma_f32_16x16x32_bf16(af, wb0[s], a0, 0, 0, 0);
                a1 = __builtin_amdgcn_mfma_f32_16x16x32_bf16(af, wb1[s], a1, 0, 0, 0);
            }
#pragma unroll
            for (int j = 0; j < 4; ++j) { PL[(w * 16 + 4 * fq + j) * 32 + fr] = a0[j]; PL[(w * 16 + 4 * fq + j) * 32 + 16 + fr] = a1[j]; }
        }
        __syncthreads();
        {
            const int tl = F.tid >> 5, e = F.tid & 31; float cur = F.b_router[e];
#pragma unroll
            for (int q = 0; q < 8; ++q) cur += PL[(q * 16 + tl) * 32 + e];
            float tv[4]; int ti[4];
#pragma unroll
            for (int k = 0; k < 4; ++k) {
                float bv = cur; int bi = e;
#pragma unroll
                for (int o = 16; o > 0; o >>= 1) { const float ov = __shfl_xor(bv, o, 32); const int oi = __shfl_xor(bi, o, 32);
                    const bool take = (ov > bv) || (ov == bv && oi < bi); bv = take ? ov : bv; bi = take ? oi : bi; }
                tv[k] = bv; ti[k] = bi; if (e == bi) cur = -__builtin_inff();
            }
            float ex[4], sum = 0.f;
#pragma unroll
            for (int k = 0; k < 4; ++k) { ex[k] = __expf(tv[k] - tv[0]); sum += ex[k]; }
            const float inv = 1.0f / sum;
            if (e < 4) {
                const int me = e == 0 ? ti[0] : e == 1 ? ti[1] : e == 2 ? ti[2] : ti[3];
                const float mw = (e == 0 ? ex[0] : e == 1 ? ex[1] : e == 2 ? ex[2] : ex[3]) * inv;
                tke[(tok0 + tl) * 4 + e] = me; tkw[(tok0 + tl) * 4 + e] = mw;
                __hip_atomic_fetch_add(HS + me, 1, __ATOMIC_RELAXED, __HIP_MEMORY_SCOPE_WORKGROUP);
            }
        }
        __syncthreads();
        if (F.tid < 32) hist[unit * 32 + F.tid] = HS[F.tid];
        __syncthreads();
    }
}
__device__ __forceinline__ void p6b_dispatch(Frame& F) {
    const int* tke = (const int*)(F.ws + WS_TKE); const float* tkw = (const float*)(F.ws + WS_TKW); const int* hist = (const int*)(F.ws + WS_HIST);
    int* dest = (int*)(F.ws + WS_DEST); float* wrow = (float*)(F.ws + WS_WROW);
    LAS int* PART = (LAS int*)F.lds;
    LAS int* OFF = PART + 512;
    LAS int* EL = OFF + 32;
    LAS int* SL = EL + 64;
    constexpr int NUNIT = MTOK / 16;
    LAS int* OFFU = SL + 128;
    LAS float* WL = (LAS float*)(OFFU + 64);
    LAS int* EL2 = (LAS int*)(WL + 128);
    const bool fast = (F.G == 256);
    if (fast && F.tid >= 128 && F.tid < 256) { const int k = (F.tid - 128) >> 6, j = F.tid & 63, un = F.vcu + k * 256;
        EL2[k * 64 + j] = tke[un * 64 + j]; WL[k * 64 + j] = tkw[un * 64 + j]; }
    { const int e = F.tid & 31, p = F.tid >> 5; int s = 0; const int u1 = F.vcu, u2 = F.vcu + 256;
      int hv[32];
#pragma unroll
      for (int i = 0; i < 32; ++i) hv[i] = hist[(32 * p + i) * 32 + e];
#pragma unroll
      for (int i = 0; i < 32; ++i) { const int u = 32 * p + i; if (u == u1) OFFU[e] = s; if (u == u2) OFFU[32 + e] = s; s += hv[i]; }
      PART[p * 32 + e] = s; }
    __syncthreads();
    if (F.vcu == 0 && F.tid < 32) { int t = 0;
#pragma unroll
        for (int p = 0; p < 16; ++p) t += PART[p * 32 + F.tid];
        F.ctl[CW_CNT + F.tid] = (unsigned)t; }
    if (F.tid < 64) {
        LAS int* tp = (LAS int*)(F.lds + LDSCTL_OFF + 448); LAS int* cn = tp + 40;
        const int e = F.tid & 31; int c = 0;
#pragma unroll
        for (int p = 0; p < 16; ++p) c += PART[p * 32 + e];
        int incl = (c + 255) >> 8;
#pragma unroll
        for (int o = 1; o < 32; o <<= 1) { const int n = __shfl_up(incl, o); if ((F.tid & 31) >= o) incl += n; }
        if (F.tid < 32) { cn[e] = c; tp[e + 1] = incl; if (e == 0) tp[0] = 0; }
    }
    for (int unit = F.vcu, k = 0; unit < NUNIT; unit += F.G, ++k) {
        if (F.tid < 32) { int s = 0; const int pg = unit >> 5;
            for (int p = 0; p < pg; ++p) s += PART[p * 32 + F.tid];
            if (fast) s += OFFU[k * 32 + F.tid];
            else for (int u = pg * 32; u < unit; ++u) s += hist[u * 32 + F.tid];
            OFF[F.tid] = s; }
        if (F.tid >= 64 && F.tid < 128) EL[F.tid - 64] = fast ? EL2[k * 64 + F.tid - 64] : tke[unit * 64 + F.tid - 64];
        __syncthreads();
        if (F.tid < 64) { const int ei = EL[F.tid]; int rank = 0;
            const unsigned long long below = (1ull << F.tid) - 1ull;
#pragma unroll 4
            for (int e = 0; e < NEXP; ++e) { const unsigned long long mk = __ballot(ei == e); if (ei == e) rank = __popcll(mk & below); }
            const int slot = OFF[ei] + rank;
            dest[(size_t)ei * CAP + slot] = unit * 64 + F.tid; wrow[(size_t)ei * CAP + slot] = fast ? WL[k * 64 + F.tid] : tkw[unit * 64 + F.tid];
            SL[F.tid * 2] = ei; SL[F.tid * 2 + 1] = slot; }
        __syncthreads();
    }
    conv_pull(F, (LAS int*)(F.lds + LDSCTL_OFF + 768), false, nullptr, 0u);
}

__device__ __forceinline__ void moe_table(Frame& F, LAS int* tp, LAS int* cn) {
    if (F.tid < 64) {
        const int e = F.tid & 31;
        const int c = (int)__hip_atomic_load(F.ctl + CW_CNT + e, __ATOMIC_RELAXED, __HIP_MEMORY_SCOPE_AGENT);
        const int tl = (c + 255) >> 8;
        int incl = tl;
#pragma unroll
        for (int o = 1; o < 32; o <<= 1) { const int n = __shfl_up(incl, o); if ((F.tid & 31) >= o) incl += n; }
        if (F.tid < 32) { cn[e] = c; tp[e + 1] = incl; if (e == 0) tp[0] = 0; }
    }
    __syncthreads();
}

struct P9Row { unsigned cw[8][4]; v2u d[8]; };
__device__ __forceinline__ void p9_load(const Frame& F, int m, P9Row& R) {
    const unsigned char* CB = F.ws + WS_CONTRIB;
    const v2u* dr = (const v2u*)((const bf16*)(F.ws + WS_X1) + (size_t)m * DM) + F.lane;
#pragma unroll
    for (int j = 0; j < 8; ++j) {
#pragma unroll
        for (int k = 0; k < 4; ++k) R.cw[j][k] = __builtin_nontemporal_load((const unsigned*)(CB + ((size_t)m * 4 + k) * DM) + 64 * j + F.lane);
        R.d[j] = __builtin_nontemporal_load(dr + 64 * j);
    }
}
__device__ __forceinline__ void p9_row(const Frame& F, int m, const P9Row& R) {
    const float* mod = (const float*)(F.ws + WS_MOD);
    const int b = m >> 12;
    const f32x4* g2 = (const f32x4*)(mod + (size_t)b * 12288 + 10240) + F.lane;
    f32x4 v[8]; float s = 0.f;
#pragma unroll
    for (int j = 0; j < 8; ++j) {
        f32x4 mo = {0.f, 0.f, 0.f, 0.f};
#pragma unroll
        for (int k = 0; k < 4; ++k) { const unsigned cw = R.cw[j][k];
            const f32x2 lo = __builtin_amdgcn_cvt_pk_f32_fp8(cw, false), hi = __builtin_amdgcn_cvt_pk_f32_fp8(cw, true);
            mo.x += lo.x; mo.y += lo.y; mo.z += hi.x; mo.w += hi.y; }
        mo = mo * 0.0625f;
        const v2u dw = R.d[j];
        v[j] = (f32x4){bflo(dw.x), bfhi(dw.x), bflo(dw.y), bfhi(dw.y)} + g2[64 * j] * mo;
        s += (v[j].x * v[j].x + v[j].y * v[j].y) + (v[j].z * v[j].z + v[j].w * v[j].w);
    }
    const float rstd = 1.0f / sqrtf(wave_sum(s) * (1.0f / DM) + EPS);
    const f32x4* fg = (const f32x4*)F.final_g + F.lane;
    f32x4* o = (f32x4*)(F.out + (size_t)m * DM) + F.lane;
#pragma unroll
    for (int j = 0; j < 8; ++j) __builtin_nontemporal_store(v[j] * rstd * fg[64 * j], o + 64 * j);
}
__device__ __forceinline__ void p9_final(Frame& F) {
    const int gw = F.vcu * NWAVES + F.wave, NGW = F.G * NWAVES;
    for (int m = gw; m < MTOK; m += 4 * NGW) {
        P9Row R[4];
#pragma unroll
        for (int q = 0; q < 4; ++q) if (m + q * NGW < MTOK) p9_load(F, m + q * NGW, R[q]);
#pragma unroll
        for (int q = 0; q < 4; ++q) if (m + q * NGW < MTOK) p9_row(F, m + q * NGW, R[q]);
    }
}

struct Args { const float* in[16]; float* out; unsigned char* ws; int ph_lo, ph_hi, li, pad; };
__global__ void __launch_bounds__(NWAVES * 64, 2) mega_fwd(Args args) {
    extern __shared__ __attribute__((aligned(16))) unsigned char lds[];
    Frame F;
    F.lds = (LAS unsigned char*)lds;
    F.tid = threadIdx.x; F.lane = F.tid & 63; F.wave = __builtin_amdgcn_readfirstlane(F.tid >> 6);
    F.G = gridDim.x; { const int bx = blockIdx.x; F.vcu = (F.G % 8 == 0) ? (bx % 8) * (F.G / 8) + bx / 8 : bx; }
    F.ws = args.ws; F.ctl = (unsigned*)(args.ws + WS_CTL); F.out = args.out;
    F.x = args.in[0]; F.c = args.in[1]; F.norm1_g = args.in[2]; F.w_mod = args.in[3]; F.b_mod = args.in[4]; F.w_in = args.in[5]; F.conv_w = args.in[6]; F.w_out = args.in[7];
    F.norm2_g = args.in[8]; F.w_router = args.in[9]; F.b_router = args.in[10]; F.w_gu = args.in[11]; F.b_gu = args.in[12]; F.w_dn = args.in[13]; F.b_dn = args.in[14]; F.final_g = args.in[15];
    volatile LAS unsigned* MISC = (volatile LAS unsigned*)(F.lds + MISC_OFF);
    for (int u = F.tid; u < (LDS_BYTES - LDSCTL_OFF) / 4; u += NWAVES * 64) ((LAS unsigned*)(F.lds + LDSCTL_OFF))[u] = 0u;
    __syncthreads();
    XcdBarrier bar; bar.bar = F.ctl + CW_BAR; bar.x = 0; bar.st = nullptr;
    if (N_LAUNCHES != PER_PHASE) bar = xcd_barrier_post(F.ctl + CW_BAR, MISC + 8);
#define GRID_BAR() do { if (N_LAUNCHES != PER_PHASE) xcd_barrier(bar); } while (0)
    const int lo = args.ph_lo, hi = args.ph_hi;
#define IN(k) (lo <= (k) && (k) < hi)
#define BOTH(k) (IN(k) && IN((k) + 1))
    LAS int* TP = (LAS int*)(F.lds + LDSCTL_OFF + 448);
    LAS int* CN = TP + 40;

    if (IN(0)) { RUN(0, p0_prologue(F)); if (BOTH(0)) GRID_BAR(); }
    if (IN(1)) { RUN(1, p1_norm1(F)); if (BOTH(1)) GRID_BAR(); }
    LAS int* QSLOT = (LAS int*)(F.lds + LDSCTL_OFF + 768);
    const int xcd_ = F.vcu >> 5, jx_ = F.vcu & 31;
    if (IN(2)) {
        constexpr int NCX = NCONV2;
        const bool split = (F.G == 256);
        if (!split || jx_ >= NCX) {
            pg8::DenseOrder S; if (split) S.init(DM * 2, MTOK, NPROJ, (32 - NCX) * 8, (jx_ - NCX) * 8 + xcd_); else S.init(DM * 2, MTOK, NPROJ, F.G, (int)blockIdx.x);
            pg8::EpiProj E{0x7f7f7f7f, (bf16*)(F.ws + WS_PROJ), NPROJ};
            RUN(2, pg8::gemm_phase<pg8::EpiProj, pg8::DenseOrder, false>(F.lds, F.ws + WS_H, F.ws + WS_WIN, DM * 2, NPROJ, S, E));
            if (F.tid == 0) __hip_atomic_fetch_add(F.ctl + CW_DONE2, 1u, __ATOMIC_RELAXED, __HIP_MEMORY_SCOPE_AGENT);
        }
        if (split) conv_pull(F, QSLOT, false, F.ctl + CW_DONE2, (unsigned)((32 - NCX) * 8));
        if (BOTH(2)) GRID_BAR();
    }
    if (IN(3)) { RUN(3, p3a_scan_conv(F)); GRID_BAR(); p3b_carry(F); if (BOTH(3)) GRID_BAR(); }
    if (IN(4)) { RUN(4, p4_retention(F)); if (BOTH(4)) GRID_BAR(); }
    if (IN(5)) {
        constexpr int NCX = NCONV5;
        const bool split = (F.G == 256);
        if (!split || jx_ >= NCX) {
            constexpr int KBO = OUT_FP8 ? DM : DM * 2;
            pg8::DenseOrder S; if (split) S.init(KBO, MTOK, DM, (32 - NCX) * 8, (jx_ - NCX) * 8 + xcd_); else S.init(KBO, MTOK, DM, F.G, (int)blockIdx.x);
            pg8::EpiDelta E{OUT_FP8 ? 0x79797979 : 0x7f7f7f7f, (const float*)(F.ws + WS_MOD), (bf16*)(F.ws + WS_X1)};
            RUN(5, pg8::gemm_phase<pg8::EpiDelta, pg8::DenseOrder, OUT_FP8 != 0>(F.lds, F.ws + WS_Y, F.ws + WS_WOUT, KBO, DM, S, E));
            if (F.tid == 0) __hip_atomic_fetch_add(F.ctl + CW_DONE5, 1u, __ATOMIC_RELAXED, __HIP_MEMORY_SCOPE_AGENT);
        }
        if (split) conv_pull(F, QSLOT, false, F.ctl + CW_DONE5, (unsigned)((32 - NCX) * 8));
        if (BOTH(5)) GRID_BAR();
    }
    if (IN(6)) { RUN(6, p6a_router(F)); if (BOTH(6)) GRID_BAR(); }
    if (IN(7)) { RUN(7, p6b_dispatch(F)); if (BOTH(7)) GRID_BAR(); }
    if (IN(8)) {
        const bool split = (F.G == 256);
        if (N_LAUNCHES == PER_PHASE) moe_table(F, TP, CN);
        int NCX = NCONV8;
        { const int U = TP[NEXP] * 16, R = (U + (255 - 8 * NCONV8)) / (256 - 8 * NCONV8);
          if (R > 0) { const int gp = (((U + R - 1) / R) + 7) & ~7; NCX = 32 - gp / 8; if (NCX < NCONV8) NCX = NCONV8; if (NCX > 16) NCX = 16; } }
        if (!split || jx_ >= NCX) {
            pg8::MoeOrder S{TP, CN, 16, split ? (32 - NCX) * 8 : F.G, split ? xcd_ * (32 - NCX) + (jx_ - NCX) : F.vcu, (unsigned)(DM * 2 * DFF * MOE_ES), 1, (const int*)(F.ws + WS_DEST)};
            pg8::EpiGateUp E{0x79797979, F.b_gu, F.ws + WS_ACT};
            RUN(8, pg8::gemm_phase<pg8::EpiGateUp, pg8::MoeOrder, MOE_FP8 != 0, true>(F.lds, F.ws + WS_H, F.ws + WS_WGU, DM * MOE_ES, 2 * DFF, S, E));
        }
        conv_pull(F, QSLOT, true, nullptr, 0u);
        if (BOTH(8)) GRID_BAR();
    }
    if (IN(9)) {
        if (N_LAUNCHES == PER_PHASE) moe_table(F, TP, CN);
        pg8::MoeOrder S{TP, CN, 8, F.G, F.vcu, (unsigned)(DFF * DM * MOE_ES), 0, nullptr};
        pg8::EpiDown E{0x79797979, F.b_dn, (const int*)(F.ws + WS_DEST), (const float*)(F.ws + WS_WROW), F.ws + WS_CONTRIB};
        RUN(9, pg8::gemm_phase<pg8::EpiDown, pg8::MoeOrder, MOE_FP8 != 0>(F.lds, F.ws + WS_ACT, F.ws + WS_WDN, DFF * MOE_ES, DM, S, E));
        if (BOTH(9)) GRID_BAR();
    }
    if (IN(10)) { RUN(10, p9_final(F)); }
#undef IN
#undef BOTH
}

extern "C" void kernel_launch(void* const* d_in, const int* in_sizes, int n_in, void* d_out, int out_size, void* d_ws, size_t ws_size, hipStream_t stream) {
    static int grid = 0;
    if (grid == 0) {
        if (n_in != 16 || out_size != MTOK * DM || ws_size < WS_END) { fprintf(stderr, "kernel_launch: unexpected shapes (n_in %d out %d ws %zu)\n", n_in, out_size, ws_size); grid = -1; return; }
        int dev = 0, cus = 0, per_cu = 0;
        if (hipGetDevice(&dev) != hipSuccess || hipDeviceGetAttribute(&cus, hipDeviceAttributeMultiprocessorCount, dev) != hipSuccess) { grid = -1; return; }
        if (hipFuncSetAttribute((const void*)mega_fwd, hipFuncAttributeMaxDynamicSharedMemorySize, LDS_BYTES) != hipSuccess) { grid = -1; return; }
        if (hipOccupancyMaxActiveBlocksPerMultiprocessor(&per_cu, (const void*)mega_fwd, NWAVES * 64, LDS_BYTES) != hipSuccess || per_cu < 1)
            fprintf(stderr, "kernel_launch: occupancy query reports %d workgroups per CU\n", per_cu);
        (void)hipGetLastError();
        grid = cus;
    }
    if (grid < 0) return;
    if (hipMemsetAsync((char*)d_ws + WS_CTL, 0, CTL_ZERO_BYTES, stream) != hipSuccess) return;
    Args a{};
    for (int i = 0; i < 16; ++i) a.in[i] = (const float*)d_in[i];
    a.out = (float*)d_out; a.ws = (unsigned char*)d_ws;
    for (int li = 0; li < N_LAUNCHES; ++li) {
        a.ph_lo = (N_LAUNCHES == PER_PHASE) ? li : 0; a.ph_hi = (N_LAUNCHES == PER_PHASE) ? li + 1 : PER_PHASE; a.li = li; a.pad = 0;
        hipLaunchKernelGGL(mega_fwd, dim3(grid), dim3(NWAVES * 64), LDS_BYTES, stream, a);
        const hipError_t le = hipPeekAtLastError();
        if (le != hipSuccess) { fprintf(stderr, "kernel_launch: launch %d failed: %s\n", li, hipGetErrorName(le)); break; }
    }
}
```

```cpp
#include <hip/hip_runtime.h>
#include <cstdio>
#include <cstdint>

#ifndef MK_N_LAUNCHES
#define MK_N_LAUNCHES 1
#endif
#ifndef MOE_FP8
#define MOE_FP8 1
#endif
#ifndef NCONV2
#define NCONV2 9
#endif
#ifndef NCONV5
#define NCONV5 16
#endif
#ifndef NCONV8
#define NCONV8 4
#endif
#ifndef OUT_FP8
#define OUT_FP8 1
#endif
#ifndef PROBE_DUP
#define CONV_ST_AUX 16
#define PROBE_DUP -1
#endif
#define RUN(k, ...) do { __VA_ARGS__; if (PROBE_DUP == (k)) { __VA_ARGS__; } } while (0)

#define GAS __attribute__((address_space(1)))
#define LAS __attribute__((address_space(3)))
typedef unsigned short bf16;
typedef unsigned v4u __attribute__((ext_vector_type(4)));
typedef unsigned v2u __attribute__((ext_vector_type(2)));
typedef float f32x4 __attribute__((ext_vector_type(4)));
typedef float f32x2 __attribute__((ext_vector_type(2)));
typedef float f32x16 __attribute__((ext_vector_type(16)));
typedef short bf16x8 __attribute__((ext_vector_type(8)));
typedef int v8i __attribute__((ext_vector_type(8)));
typedef int v4i __attribute__((ext_vector_type(4)));

constexpr int NBATCH = 2, SEQ = 4096, DM = 2048, MTOK = NBATCH * SEQ;
constexpr int DRET = 1024, NHEAD = 8, HD = 128, CHUNK = 64, NCHUNK = SEQ / CHUNK;
constexpr int NPROJ = 7168, NEXP = 32, TOPK = 4, DFF = 2048, CAP = 8192;
constexpr float EPS = 1e-6f;
constexpr int PER_PHASE = 11;
constexpr int N_LAUNCHES = MK_N_LAUNCHES;
constexpr int NWAVES = 8;
constexpr int MOE_ES = MOE_FP8 ? 1 : 2;
constexpr int MOE_G = 16 / MOE_ES;

constexpr size_t MiB = 1u << 20;
constexpr size_t WS_CTL = 0, CTL_ZERO_BYTES = 128 * 1024;
constexpr size_t WS_MOD = 2 * MiB;
constexpr size_t WS_COS = 3 * MiB, WS_SIN = 4 * MiB;
constexpr size_t WS_WRT = 5 * MiB;
constexpr size_t WS_WIN = 8 * MiB;
constexpr size_t WS_WOUT = 40 * MiB;
constexpr size_t WS_H = 64 * MiB;
constexpr size_t WS_PROJ = 96 * MiB;
constexpr size_t WS_ST = 208 * MiB;
constexpr size_t WS_Y = 240 * MiB;
constexpr size_t WS_X1 = 272 * MiB;
constexpr size_t WS_DEST = 336 * MiB, WS_WROW = 337 * MiB;
constexpr size_t WS_TKE = 338 * MiB, WS_TKW = 339 * MiB, WS_HIST = 340 * MiB;
constexpr size_t WS_CONTRIB = 344 * MiB;
constexpr size_t WS_WGU = 512 * MiB;
constexpr size_t WS_WDN = 1024 * MiB;
constexpr size_t WS_TT = 1280 * MiB;
constexpr size_t WS_CARRY = 1296 * MiB;
constexpr size_t WS_ACT = 2304 * MiB;
constexpr size_t WS_END = 3328 * MiB;
constexpr int CW_TMO = 0, CW_BAR = 4096, CW_CNT = 16384, CW_CHEAD = 16448, CW_DONE2 = 16512, CW_DONE5 = 16576, CW_CHEAD_DN = 16640, CW_DONE8 = 16704;

constexpr int RING_BYTES = 131072;
constexpr int LDSCTL_OFF = RING_BYTES, MISC_OFF = LDSCTL_OFF + 320;
constexpr int LDS_BYTES = 147456;

__device__ __forceinline__ unsigned cvt_pk_bf16(float lo, float hi) { unsigned r; asm volatile("v_cvt_pk_bf16_f32 %0, %1, %2" : "=v"(r) : "v"(lo), "v"(hi)); return r; }
__device__ __forceinline__ float bflo(unsigned w) { return __uint_as_float(w << 16); }
__device__ __forceinline__ float bfhi(unsigned w) { return __uint_as_float(w & 0xffff0000u); }
__device__ __forceinline__ float wave_sum(float v) {
#pragma unroll
    for (int o = 1; o < 64; o <<= 1) v += __shfl_xor(v, o);
    return v;
}
__device__ __forceinline__ unsigned pk4_fp8(float a, float b, float c, float d) {
    unsigned w = 0; w = __builtin_amdgcn_cvt_pk_fp8_f32(a, b, w, false); w = __builtin_amdgcn_cvt_pk_fp8_f32(c, d, w, true); return w;
}
__device__ __forceinline__ float lg2gamma(int h) {
    const float e = __builtin_amdgcn_exp2f((float)(-5 - h));
    const float s = e * (1.f + e * (0.5f + e * (0.33333334f + e * (0.25f + e * (0.2f + e * (0.16666667f + e * 0.14285715f))))));
    return -s * 1.4426950408889634f;
}
#define LDS_WAIT() asm volatile("s_waitcnt lgkmcnt(0)" ::: "memory")
#define LDS_BARRIER() do { asm volatile("s_waitcnt lgkmcnt(0)" ::: "memory"); __builtin_amdgcn_s_barrier(); asm volatile("" ::: "memory"); } while (0)
#define VM_WAIT() asm volatile("s_waitcnt vmcnt(0)" ::: "memory")

#define XB_TMO      128
#define XB_XCNT(j)  (256  + 64 * (j))
#define XB_XSUB(j)  (1280 + 64 * (j))
#define XB_XGEN(j)  (2304 + 64 * (j))
#define XB_TOP      3328
#define XB_TOPGEN   3392
#define XCD_BAR_WORDS 3456
#define XB_SPIN_CAP (1u << 18)
__device__ __forceinline__ unsigned xb_ld(unsigned* p)              { return __hip_atomic_load(p, __ATOMIC_RELAXED, __HIP_MEMORY_SCOPE_AGENT); }
__device__ __forceinline__ unsigned xb_add(unsigned* p, unsigned v) { return __hip_atomic_fetch_add(p, v, __ATOMIC_RELAXED, __HIP_MEMORY_SCOPE_AGENT); }
__device__ __forceinline__ unsigned xb_xcc_id() { return (unsigned)__builtin_amdgcn_s_getreg((3 << 11) | 20) & 0xFu; }
#define XB_SPIN(cond, bar) do { unsigned _sp = 0; while (cond) { __builtin_amdgcn_s_sleep(1); \
    if ((++_sp & 255u) == 0u) { if (xb_ld(&(bar)[XB_TMO])) break; if (_sp > XB_SPIN_CAP) { atomicAdd(&(bar)[XB_TMO], 1u); break; } } } } while (0)
struct XcdBarrier { unsigned* bar; unsigned x; volatile LAS unsigned* st; };
__device__ __forceinline__ XcdBarrier xcd_barrier_post(unsigned* bar, volatile LAS unsigned* st) {
    XcdBarrier b; b.bar = bar; b.x = xb_xcc_id(); b.st = st;
    if (threadIdx.x == 0) (void)xb_add(&bar[XB_XCNT(b.x)], 1u);
    return b;
}
__device__ __forceinline__ void xcd_barrier_complete(unsigned* bar, unsigned x, unsigned& nloc, unsigned& nx) {
    const unsigned G = gridDim.x * gridDim.y * gridDim.z;
    unsigned sum, cnt, mine, sp = 0u;
    for (;;) {
        sum = 0u; cnt = 0u; mine = 0u;
#pragma unroll
        for (unsigned j = 0; j < 16; ++j) { const unsigned c = xb_ld(&bar[XB_XCNT(j)]); sum += c; cnt += (c > 0u) ? 1u : 0u; mine = (j == x) ? c : mine; }
        if (sum == G) break;
        __builtin_amdgcn_s_sleep(1);
        if ((++sp & 255u) == 0u) { if (xb_ld(&bar[XB_TMO])) break; if (sp > XB_SPIN_CAP) { atomicAdd(&bar[XB_TMO], 1u); break; } }
    }
    nloc = mine > 0u ? mine : 1u; nx = cnt > 0u ? cnt : 1u;
}
__device__ __forceinline__ void xcd_barrier(const XcdBarrier& b) {
    asm volatile("s_waitcnt vmcnt(0)" ::: "memory");
    __syncthreads();
    if (threadIdx.x == 0) {
        unsigned* bar = b.bar;
        __builtin_amdgcn_s_waitcnt(0);
        unsigned nloc = b.st[0], nx = b.st[1];
        if (nloc == 0u) { xcd_barrier_complete(bar, b.x, nloc, nx); b.st[0] = nloc; b.st[1] = nx; }
        const unsigned old = xb_add(&bar[XB_XSUB(b.x)], 1u);
        const unsigned gen = old / nloc;
        if (old + 1u == (gen + 1u) * nloc) {
            __builtin_amdgcn_fence(__ATOMIC_RELEASE, "agent");
            asm volatile("s_waitcnt vmcnt(0)" ::: "memory");
            const unsigned og = xb_add(&bar[XB_TOP], 1u);
            const unsigned tg = og / nx;
            if (og + 1u == (tg + 1u) * nx) xb_add(&bar[XB_TOPGEN], 1u);
            else XB_SPIN(xb_ld(&bar[XB_TOPGEN]) == tg, bar);
            __builtin_amdgcn_fence(__ATOMIC_ACQUIRE, "agent");
            asm volatile("s_waitcnt vmcnt(0)" ::: "memory");
        } else {
            XB_SPIN(xb_ld(&bar[XB_TOPGEN]) == gen, bar);
            __builtin_amdgcn_fence(__ATOMIC_ACQUIRE, "agent");
            asm volatile("s_waitcnt vmcnt(0)" ::: "memory");
        }
    }
    __syncthreads();
}

namespace pg8 {
constexpr int BM = 256, HALF = 128, HTB = HALF * 128, STAGE_BYTES = 8 * HTB, NXCD = 8, WGM = 8;
__host__ __device__ __forceinline__ int lds_byte(int r, int c) { const int st = (r >> 4) * 2 + (c >> 5), rr = r & 15, cc = c & 31, ob = rr * 64 + cc * 2; return st * 1024 + (ob ^ (((ob >> 9) & 1) << 5)); }
__host__ __device__ __forceinline__ void stage_rc(int b, int& R, int& C) { const int st = b / 1024, sb = b % 1024, swz = sb ^ (((sb >> 9) & 1) << 5); R = (st >> 1) * 16 + swz / 64; C = (st & 1) * 32 + (swz % 64) / 2; }
__host__ __device__ __forceinline__ int perm32(int rho) { const int n = rho >> 4, i = rho & 15; return 8 * (i >> 2) + 4 * n + (i & 3); }

struct Unit { unsigned a, b0, b1; int row0, pn, e, cnt; };

struct DenseOrder {
    int KB, nM, nN, nwg, G, c; const int* rowtok = nullptr;
    __device__ void init(int KB_, int M, int N, int G_, int c_) { KB = KB_; nM = M / BM; nN = N / BM; nwg = nM * nN; G = G_; c = c_; }
    __device__ bool next(int i, Unit& u) const {
        const long L = (long)i * G + c; if (L >= nwg) return false;
        int wgid = (int)L; { const int q = nwg / NXCD, r = nwg % NXCD, xcd = wgid % NXCD, off = wgid / NXCD; wgid = (xcd < r ? xcd * (q + 1) : r * (q + 1) + (xcd - r) * q) + off; }
        const int nig = WGM * nN, gid = wgid / nig, fm = gid * WGM, gsz = (nM - fm) < WGM ? (nM - fm) : WGM;
        const int pm = fm + ((wgid % nig) % gsz), pn = (wgid % nig) / gsz;
        u.a = (unsigned)pm * BM * KB; u.b0 = (unsigned)pn * BM * 16; u.b1 = u.b0 + HALF * 16; u.row0 = pm * BM; u.pn = pn; u.e = 0; u.cnt = 0x7fffffff; return true;
    }
};

template <class Epi, class Sched, bool FP8, bool GATHER = false>
__device__ __forceinline__ void gemm_phase(LAS unsigned char* lds, const void* Abase, const void* Bbase, const int KB  , const int NB  , const Sched& S, const Epi& E) {
    const int tid = threadIdx.x, wid = __builtin_amdgcn_readfirstlane(tid >> 6), lane = tid & 63, wr = wid >> 2, wc = wid & 3, fr = lane & 15, fq = lane >> 4;
    const int nt = KB / 128;
    unsigned voffA[2], voffB[2];
#pragma unroll
    for (int i = 0; i < 2; ++i) { int R, C; stage_rc(tid * 16 + i * 8192, R, C); const int Rb = Epi::PERM ? ((R & ~31) + perm32(R & 31)) : R;
        voffA[i] = (unsigned)(R * KB + C * 2); voffB[i] = (unsigned)(((C >> 3) * NB + Rb) * 16); }
    unsigned vA[2][2] = {{0u, 0u}, {0u, 0u}};
    LAS int* TOK = (LAS int*)(lds + STAGE_BYTES + 1024);
#define PG8_GATHER_OFFS() do { _Pragma("unroll") for (int _h = 0; _h < 2; ++_h) _Pragma("unroll") for (int _i = 0; _i < 2; ++_i) { int R_, C_; stage_rc(tid * 16 + _i * 8192, R_, C_); \
        vA[_h][_i] = (unsigned)TOK[_h * HALF + R_] * (unsigned)KB + (unsigned)(C_ * 2); } } while (0)
#define PG8_FILL_TOK(un) do { if (tid < 256) { const int r_ = (un).row0 + tid; TOK[tid] = (r_ < (un).cnt) ? (S.rowtok[(size_t)(un).e * CAP + r_] >> 2) : 0; } } while (0)
    const unsigned kstepA = 128, kstepB = (unsigned)8 * NB * 16;
    const unsigned hstepA = (unsigned)HALF * KB;
    const __amdgpu_buffer_rsrc_t rA = __builtin_amdgcn_make_buffer_rsrc((void*)Abase, 0, 0xfffffff0, 0x00020000);
    const __amdgpu_buffer_rsrc_t rB = __builtin_amdgcn_make_buffer_rsrc((void*)Bbase, 0, 0xfffffff0, 0x00020000);
    const unsigned ldsw = (unsigned)wid * 1024u;
    const int aoff = lds_byte(wr * 64 + fr, fq * 8), boff = lds_byte(wc * 32 + fr, fq * 8);
#define PG8_SA(b, h) (((b) * 2 + (h)) * HTB)
#define PG8_SB(b, h) ((4 + (b) * 2 + (h)) * HTB)
#define PG8_STAGE(bufoff, rs, soff, voff) do { _Pragma("unroll") for (int _i = 0; _i < 2; ++_i) \
        __builtin_amdgcn_raw_ptr_buffer_load_lds(rs, (LAS void*)(lds + (bufoff) + ldsw + _i * 8192), 16, (int)(voff)[_i], (int)(soff), 0, 0); } while (0)
#define PG8_STAGE_A(bufoff, h, soff) do { if constexpr (GATHER) { PG8_STAGE(bufoff, rA, soff, vA[h]); } else { PG8_STAGE(bufoff, rA, (soff) + (h) * hstepA, voffA); } } while (0)
#define PG8_LD8(p) __builtin_shufflevector(*(const LAS v4i*)(p), *(const LAS v4i*)((p) + 1024), 0, 1, 2, 3, 4, 5, 6, 7)
#define PG8_LDA(dst, b, h) do { _Pragma("unroll") for (int m = 0; m < 4; ++m) dst[m] = PG8_LD8(lds + PG8_SA(b, h) + aoff + m * 2048); } while (0)
#define PG8_LDB(dst, b, h) do { _Pragma("unroll") for (int n = 0; n < 2; ++n) dst[n] = PG8_LD8(lds + PG8_SB(b, h) + boff + n * 2048); } while (0)
#define PG8_LO(v) __builtin_bit_cast(bf16x8, __builtin_shufflevector(v, v, 0, 1, 2, 3))
#define PG8_HI(v) __builtin_bit_cast(bf16x8, __builtin_shufflevector(v, v, 4, 5, 6, 7))
#define PG8_MMA(ai, bj, At, Bt) do { __builtin_amdgcn_s_setprio(1); _Pragma("unroll") for (int m = 0; m < 4; ++m) _Pragma("unroll") for (int n = 0; n < 2; ++n) { \
        if constexpr (FP8) { asm volatile("v_mfma_scale_f32_16x16x128_f8f6f4 %0, %1, %2, %0, %3, %4 op_sel_hi:[0,0,0]" : "+v"(acc[ai][bj][m][n]) : "v"(Bt[n]), "v"(At[m]), "v"(sclB), "v"(sclA)); } \
        else { acc[ai][bj][m][n] = __builtin_amdgcn_mfma_f32_16x16x32_bf16(PG8_LO(Bt[n]), PG8_LO(At[m]), acc[ai][bj][m][n], 0, 0, 0); \
               acc[ai][bj][m][n] = __builtin_amdgcn_mfma_f32_16x16x32_bf16(PG8_HI(Bt[n]), PG8_HI(At[m]), acc[ai][bj][m][n], 0, 0, 0); } } \
        __builtin_amdgcn_s_setprio(0); } while (0)
#define PG8_MMA_Z(ai, bj, At, Bt) do { __builtin_amdgcn_s_setprio(1); _Pragma("unroll") for (int m = 0; m < 4; ++m) _Pragma("unroll") for (int n = 0; n < 2; ++n) { \
        if constexpr (FP8) { asm volatile("v_mfma_scale_f32_16x16x128_f8f6f4 %0, %1, %2, 0, %3, %4 op_sel_hi:[0,0,0]" : "=&v"(acc[ai][bj][m][n]) : "v"(Bt[n]), "v"(At[m]), "v"(sclB), "v"(sclA)); } \
        else { acc[ai][bj][m][n] = __builtin_amdgcn_mfma_f32_16x16x32_bf16(PG8_LO(Bt[n]), PG8_LO(At[m]), (f32x4){0.f, 0.f, 0.f, 0.f}, 0, 0, 0); \
               acc[ai][bj][m][n] = __builtin_amdgcn_mfma_f32_16x16x32_bf16(PG8_HI(Bt[n]), PG8_HI(At[m]), acc[ai][bj][m][n], 0, 0, 0); } } \
        __builtin_amdgcn_s_setprio(0); } while (0)
#define PG8_WAIT_V(n) asm volatile("s_waitcnt vmcnt(" #n ")" ::: "memory")
#define PG8_WAIT_L(n) asm volatile("s_waitcnt lgkmcnt(" #n ")" ::: "memory")
#define PG8_BAR __builtin_amdgcn_s_barrier()
#define PG8_SCHED __builtin_amdgcn_sched_barrier(0)
    Unit cur, nxt; int ui = 0;
    if (!S.next(0, cur)) return;
    const int sclB = E.scale_b, sclA = 0x7f7f7f7f;
    f32x4 acc[2][2][4][2];
    v8i At[4], B0[2], B1[2];
    unsigned cA = cur.a, cB0 = cur.b0, cB1 = cur.b1;
    Unit nn; bool h1 = false, h2 = false; int tokv = 0;
#define PG8_TOK_REQ(un) do { if (tid < 256) tokv = S.rowtok[(size_t)(un).e * CAP + (un).row0 + tid]; } while (0)
#define PG8_TOK_PUT(un) do { if (tid < 256) TOK[tid] = ((un).row0 + tid < (un).cnt) ? (tokv >> 2) : 0; } while (0)
    if constexpr (GATHER) { PG8_FILL_TOK(cur); PG8_WAIT_L(0); PG8_BAR; PG8_GATHER_OFFS(); PG8_WAIT_L(0); PG8_BAR;
        h1 = S.next(1, nxt); if (h1) PG8_TOK_REQ(nxt); }
    PG8_STAGE(PG8_SB(0, 0), rB, cB0, voffB); PG8_STAGE(PG8_SB(0, 1), rB, cB1, voffB); PG8_STAGE_A(PG8_SA(0, 0), 0, cA); PG8_STAGE_A(PG8_SA(0, 1), 1, cA);
    if (wr == 1) PG8_BAR;
    PG8_WAIT_V(2); PG8_BAR;
    PG8_STAGE(PG8_SB(1, 0), rB, cB0 + kstepB, voffB); PG8_STAGE_A(PG8_SA(1, 0), 0, cA + kstepA); PG8_STAGE(PG8_SB(1, 1), rB, cB1 + kstepB, voffB);
    PG8_WAIT_V(6); PG8_BAR;
    for (;;) {
        bool has_next;
        if constexpr (GATHER) has_next = h1; else has_next = S.next(ui + 1, nxt);
        const unsigned nA = has_next ? nxt.a : cA, nB0 = has_next ? nxt.b0 : cB0, nB1 = has_next ? nxt.b1 : cB1;
        if constexpr (GATHER) { if (has_next) PG8_TOK_PUT(nxt); }
        LAS unsigned char* epl = lds + STAGE_BYTES + 2048 + (ui & 1) * 3072;
        E.prefetch(epl, cur, tid, wid);
        const bool skipw = !Epi::DENSE && wr == 1 && (cur.cnt - cur.row0) <= 64;
        const bool halfu = !Epi::DENSE && (cur.cnt - cur.row0) <= HALF;
        {
            const int t = 0;
            const bool last = (t == nt - 2);
            const unsigned a1 = cA + (unsigned)(t + 1) * kstepA;
            const unsigned a2 = last ? nA : cA + (unsigned)(t + 2) * kstepA;
            const unsigned b20 = last ? nB0 : cB0 + (unsigned)(t + 2) * kstepB, b21 = last ? nB1 : cB1 + (unsigned)(t + 2) * kstepB;
            const unsigned a3 = a2 + kstepA, b30 = b20 + kstepB, b31 = b21 + kstepB;
            if (!skipw) { PG8_LDB(B0, 0, 0); PG8_LDB(B1, 0, 1); PG8_SCHED; PG8_LDA(At, 0, 0); } PG8_STAGE_A(PG8_SA(1, 1), 1, a1);
            PG8_WAIT_V(8); PG8_WAIT_L(0); PG8_BAR; if (!skipw) { PG8_MMA_Z(0, 0, At, B0); PG8_MMA_Z(0, 1, At, B1); } PG8_BAR; PG8_SCHED;
            if constexpr (GATHER) { if (last && has_next) PG8_GATHER_OFFS(); }
            if (!halfu) PG8_LDA(At, 0, 1); PG8_STAGE(PG8_SB(0, 0), rB, b20, voffB); PG8_STAGE(PG8_SB(0, 1), rB, b21, voffB); PG8_STAGE_A(PG8_SA(0, 0), 0, a2);
            PG8_WAIT_V(8); PG8_WAIT_L(0); PG8_BAR; if (!halfu) { PG8_MMA_Z(1, 0, At, B0); PG8_MMA_Z(1, 1, At, B1); } PG8_BAR; PG8_SCHED;
            if (!skipw) { PG8_LDB(B0, 1, 0); PG8_LDB(B1, 1, 1); PG8_SCHED; PG8_LDA(At, 1, 0); } PG8_STAGE_A(PG8_SA(0, 1), 1, a2);
            PG8_WAIT_V(8); PG8_WAIT_L(0); PG8_BAR; if (!skipw) { PG8_MMA(0, 0, At, B0); PG8_MMA(0, 1, At, B1); } PG8_BAR; PG8_SCHED;
            if (!halfu) PG8_LDA(At, 1, 1); PG8_STAGE(PG8_SB(1, 0), rB, b30, voffB); PG8_STAGE(PG8_SB(1, 1), rB, b31, voffB); PG8_STAGE_A(PG8_SA(1, 0), 0, a3);
            PG8_WAIT_V(8); PG8_WAIT_L(0); PG8_BAR; if (!halfu) { PG8_MMA(1, 0, At, B0); PG8_MMA(1, 1, At, B1); } PG8_BAR; PG8_SCHED;
        }
        for (int t = 2; t < nt; t += 2) {
            const bool last = (t == nt - 2);
            const unsigned a1 = cA + (unsigned)(t + 1) * kstepA;
            const unsigned a2 = last ? nA : cA + (unsigned)(t + 2) * kstepA;
            const unsigned b20 = last ? nB0 : cB0 + (unsigned)(t + 2) * kstepB, b21 = last ? nB1 : cB1 + (unsigned)(t + 2) * kstepB;
            const unsigned a3 = a2 + kstepA, b30 = b20 + kstepB, b31 = b21 + kstepB;
            if (!skipw) { PG8_LDB(B0, 0, 0); PG8_LDB(B1, 0, 1); PG8_SCHED; PG8_LDA(At, 0, 0); } PG8_STAGE_A(PG8_SA(1, 1), 1, a1);
            PG8_WAIT_V(8); PG8_WAIT_L(0); PG8_BAR; if (!skipw) { PG8_MMA(0, 0, At, B0); PG8_MMA(0, 1, At, B1); } PG8_BAR; PG8_SCHED;
            if constexpr (GATHER) { if (last && has_next) PG8_GATHER_OFFS(); }
            if (!halfu) PG8_LDA(At, 0, 1); PG8_STAGE(PG8_SB(0, 0), rB, b20, voffB); PG8_STAGE(PG8_SB(0, 1), rB, b21, voffB); PG8_STAGE_A(PG8_SA(0, 0), 0, a2);
            PG8_WAIT_V(8); PG8_WAIT_L(0); PG8_BAR; if (!halfu) { PG8_MMA(1, 0, At, B0); PG8_MMA(1, 1, At, B1); } PG8_BAR; PG8_SCHED;
            if (!skipw) { PG8_LDB(B0, 1, 0); PG8_LDB(B1, 1, 1); PG8_SCHED; PG8_LDA(At, 1, 0); } PG8_STAGE_A(PG8_SA(0, 1), 1, a2);
            PG8_WAIT_V(8); PG8_WAIT_L(0); PG8_BAR; if (!skipw) { PG8_MMA(0, 0, At, B0); PG8_MMA(0, 1, At, B1); } PG8_BAR; PG8_SCHED;
            if (!halfu) PG8_LDA(At, 1, 1); PG8_STAGE(PG8_SB(1, 0), rB, b30, voffB); PG8_STAGE(PG8_SB(1, 1), rB, b31, voffB); PG8_STAGE_A(PG8_SA(1, 0), 0, a3);
            PG8_WAIT_V(8); PG8_WAIT_L(0); PG8_BAR; if (!halfu) { PG8_MMA(1, 0, At, B0); PG8_MMA(1, 1, At, B1); } PG8_BAR; PG8_SCHED;
        }
        if constexpr (FP8) { asm volatile("s_nop 15\n\ts_nop 15"); }
        if constexpr (GATHER) { h2 = has_next && S.next(ui + 2, nn); if (h2) PG8_TOK_REQ(nn); }
        if (wr == 0) PG8_BAR;
        { int tz = threadIdx.x; asm volatile("" : "+v"(tz));
          E(acc, cur, wr, wc, tz & 15, (tz & 63) >> 4, epl); }
        if (!has_next) break;
        cur = nxt; cA = nA; cB0 = nB0; cB1 = nB1; ++ui;
        if constexpr (GATHER) { nxt = nn; h1 = h2; }
        if (wr == 1) PG8_BAR;
    }
    PG8_WAIT_V(0);
    PG8_BAR;
#undef PG8_SA
#undef PG8_SB
#undef PG8_STAGE
#undef PG8_LDA
#undef PG8_STAGE_A
#undef PG8_GATHER_OFFS
#undef PG8_FILL_TOK
#undef PG8_TOK_REQ
#undef PG8_TOK_PUT
#undef PG8_LD8
#undef PG8_LO
#undef PG8_HI
#undef PG8_LDB
#undef PG8_MMA
#undef PG8_MMA_Z
#undef PG8_WAIT_V
#undef PG8_WAIT_L
#undef PG8_BAR
#undef PG8_SCHED
}

struct EpiProj {
    static constexpr bool DENSE = true; static constexpr bool PERM = true; int scale_b;
    bf16* O; int ldc;
    __device__ __forceinline__ void prefetch(LAS unsigned char*, const Unit&, int, int) const {}
    __device__ __forceinline__ void operator()(const f32x4 (&acc)[2][2][4][2], const Unit& u, int wr, int wc, int fr, int fq, const LAS unsigned char*) const {
        const int row0 = u.row0 + wr * 64 + fr, col0 = u.pn * BM + wc * 32 + 8 * fq;
#pragma unroll
        for (int ai = 0; ai < 2; ++ai)
#pragma unroll
            for (int m = 0; m < 4; ++m) { bf16* rowp = O + (size_t)(row0 + ai * HALF + m * 16) * ldc + col0;
#pragma unroll
                for (int bj = 0; bj < 2; ++bj) { const f32x4 v0 = acc[ai][bj][m][0], v1 = acc[ai][bj][m][1];
                    v4u w; w.x = cvt_pk_bf16(v0[0], v0[1]); w.y = cvt_pk_bf16(v0[2], v0[3]); w.z = cvt_pk_bf16(v1[0], v1[1]); w.w = cvt_pk_bf16(v1[2], v1[3]);
                    *(v4u*)(rowp + bj * HALF) = w; } }
    }
};
struct EpiDelta {
    static constexpr bool DENSE = true; static constexpr bool PERM = true; int scale_b;
    const float* mod; bf16* out;
    __device__ __forceinline__ void prefetch(LAS unsigned char* epl, const Unit& u, int tid, int wid) const {
        if (wid < 4) { const __amdgpu_buffer_rsrc_t rs = __builtin_amdgcn_make_buffer_rsrc((void*)mod, 0, 0xfffffff0, 0x00020000);
            __builtin_amdgcn_raw_ptr_buffer_load_lds(rs, (LAS void*)(epl + wid * 256), 4, (4096 + u.pn * BM + tid) * 4, (u.row0 >> 12) * 12288 * 4, 0, 0); }
    }
    __device__ __forceinline__ void operator()(const f32x4 (&acc)[2][2][4][2], const Unit& u, int wr, int wc, int fr, int fq, const LAS unsigned char* epl) const {
        const int row0 = u.row0 + wr * 64 + fr, col0 = u.pn * BM + wc * 32 + 8 * fq;
        const LAS float* g = (const LAS float*)epl + wc * 32 + 8 * fq;
        f32x4 gv[2][2];
#pragma unroll
        for (int bj = 0; bj < 2; ++bj)
#pragma unroll
            for (int n = 0; n < 2; ++n) gv[bj][n] = *(const LAS f32x4*)(g + bj * HALF + 4 * n);
#pragma unroll
        for (int ai = 0; ai < 2; ++ai)
#pragma unroll
            for (int m = 0; m < 4; ++m) { bf16* rowp = out + (size_t)(row0 + ai * HALF + m * 16) * DM + col0;
#pragma unroll
                for (int bj = 0; bj < 2; ++bj) { const f32x4 v0 = acc[ai][bj][m][0] * gv[bj][0], v1 = acc[ai][bj][m][1] * gv[bj][1];
                    v4u w; w.x = cvt_pk_bf16(v0[0], v0[1]); w.y = cvt_pk_bf16(v0[2], v0[3]); w.z = cvt_pk_bf16(v1[0], v1[1]); w.w = cvt_pk_bf16(v1[2], v1[3]);
                    *(v4u*)(rowp + bj * HALF) = w; } }
    }
};
struct EpiGateUp {
    static constexpr bool DENSE = false; static constexpr bool PERM = true; int scale_b;
    const float* bgu; unsigned char* act;
    __device__ __forceinline__ void prefetch(LAS unsigned char* epl, const Unit& u, int tid, int wid) const {
        if (wid < 4) { const __amdgpu_buffer_rsrc_t rs = __builtin_amdgcn_make_buffer_rsrc((void*)bgu, 0, 0xfffffff0, 0x00020000);
            const int col = (wid >> 1) * 2048 + u.pn * HALF + (wid & 1) * 64 + (tid & 63);
            __builtin_amdgcn_raw_ptr_buffer_load_lds(rs, (LAS void*)(epl + wid * 256), 4, col * 4, u.e * 4096 * 4, 0, 0); }
    }
    __device__ __forceinline__ void operator()(const f32x4 (&acc)[2][2][4][2], const Unit& u, int wr, int wc, int fr, int fq, const LAS unsigned char* epl) const {
        const int c8 = u.pn * HALF + wc * 32 + 8 * fq;
        const LAS float* bb = (const LAS float*)epl + wc * 32 + 8 * fq;
        const f32x4 bg0 = *(const LAS f32x4*)(bb), bg1 = *(const LAS f32x4*)(bb + 4), bu0 = *(const LAS f32x4*)(bb + 128), bu1 = *(const LAS f32x4*)(bb + 132);
#pragma unroll
        for (int ai = 0; ai < 2; ++ai)
#pragma unroll
            for (int m = 0; m < 4; ++m) { const int row = u.row0 + ai * HALF + wr * 64 + m * 16 + fr;
                float o[8];
#pragma unroll
                for (int n = 0; n < 2; ++n) { const f32x4 gt = acc[ai][0][m][n] + (n ? bg1 : bg0), up = acc[ai][1][m][n] + (n ? bu1 : bu0);
#pragma unroll
                    for (int j = 0; j < 4; ++j) { const float gc = fminf(gt[j], 7.0f), uc = fminf(fmaxf(up[j], -7.0f), 7.0f);
                        const float sg = __builtin_amdgcn_rcpf(1.0f + __builtin_amdgcn_exp2f(-1.702f * 1.4426950408889634f * gc));
                        const float tq = gc * sg; o[n * 4 + j] = __builtin_fmaf(uc, tq, tq); } }
                if (row < u.cnt) {
                    const size_t off = ((size_t)u.e * CAP + row) * DFF + c8;
                    if constexpr (MOE_FP8) { v2u w; w.x = pk4_fp8(o[0], o[1], o[2], o[3]); w.y = pk4_fp8(o[4], o[5], o[6], o[7]); __builtin_nontemporal_store(w, (v2u*)(act + off)); }
                    else { v4u w; w.x = cvt_pk_bf16(o[0], o[1]); w.y = cvt_pk_bf16(o[2], o[3]); w.z = cvt_pk_bf16(o[4], o[5]); w.w = cvt_pk_bf16(o[6], o[7]); *(v4u*)(act + off * 2) = w; }
                } }
    }
};
struct EpiDown {
    static constexpr bool DENSE = false; static constexpr bool PERM = true; int scale_b;
    const float* bdn; const int* dest; const float* wrow; unsigned char* contrib;
    __device__ __forceinline__ void prefetch(LAS unsigned char* epl, const Unit& u, int tid, int wid) const {
        if (wid < 4) {
            const __amdgpu_buffer_rsrc_t rb = __builtin_amdgcn_make_buffer_rsrc((void*)bdn, 0, 0xfffffff0, 0x00020000);
            const __amdgpu_buffer_rsrc_t rd = __builtin_amdgcn_make_buffer_rsrc((void*)dest, 0, 0xfffffff0, 0x00020000);
            const __amdgpu_buffer_rsrc_t rw = __builtin_amdgcn_make_buffer_rsrc((void*)wrow, 0, 0xfffffff0, 0x00020000);
            __builtin_amdgcn_raw_ptr_buffer_load_lds(rb, (LAS void*)(epl + wid * 256), 4, (u.pn * BM + tid) * 4, u.e * DM * 4, 0, 0);
            __builtin_amdgcn_raw_ptr_buffer_load_lds(rd, (LAS void*)(epl + 1024 + wid * 256), 4, (u.row0 + tid) * 4, u.e * CAP * 4, 0, 0);
            __builtin_amdgcn_raw_ptr_buffer_load_lds(rw, (LAS void*)(epl + 2048 + wid * 256), 4, (u.row0 + tid) * 4, u.e * CAP * 4, 0, 0);
        }
    }
    __device__ __forceinline__ void operator()(const f32x4 (&acc)[2][2][4][2], const Unit& u, int wr, int wc, int fr, int fq, const LAS unsigned char* epl) const {
        const int col0 = u.pn * BM + wc * 32 + 8 * fq;
        const LAS float* bb = (const LAS float*)epl + wc * 32 + 8 * fq;
        f32x4 bv[2][2];
#pragma unroll
        for (int bj = 0; bj < 2; ++bj)
#pragma unroll
            for (int n = 0; n < 2; ++n) bv[bj][n] = *(const LAS f32x4*)(bb + bj * HALF + 4 * n);
        int dd[2][4]; float ww[2][4];
#pragma unroll
        for (int ai = 0; ai < 2; ++ai)
#pragma unroll
            for (int m = 0; m < 4; ++m) { const int rl = ai * HALF + wr * 64 + m * 16 + fr; dd[ai][m] = ((const LAS int*)(epl + 1024))[rl]; ww[ai][m] = ((const LAS float*)(epl + 2048))[rl]; }
#pragma unroll
        for (int ai = 0; ai < 2; ++ai)
#pragma unroll
            for (int m = 0; m < 4; ++m) { const int row = u.row0 + ai * HALF + wr * 64 + m * 16 + fr;
                if (row < u.cnt) {
                    const float w = ww[ai][m] * 16.0f;
                    unsigned char* rowp = contrib + (size_t)dd[ai][m] * DM + col0;
#pragma unroll
                    for (int bj = 0; bj < 2; ++bj) { const f32x4 v0 = (acc[ai][bj][m][0] + bv[bj][0]) * w, v1 = (acc[ai][bj][m][1] + bv[bj][1]) * w;
                        v2u o; o.x = pk4_fp8(v0[0], v0[1], v0[2], v0[3]); o.y = pk4_fp8(v1[0], v1[1], v1[2], v1[3]);
                        *(v2u*)(rowp + bj * HALF) = o; } } }
    }
};
struct MoeOrder {
    const LAS int* tp; const LAS int* cn; int npn, G, c; unsigned wstride; int gateup; const int* rowtok; const LAS int* te;
    __device__ bool next(int i, Unit& u) const {
        const int L = i * G + c; const int total = tp[NEXP] * npn; if (L >= total) return false;
        int tile = L / npn, pn = L - tile * npn;
        if (npn == 16) {
            const int nfull = tp[NEXP] >> 2, sb = L >> 6;
            if (sb < nfull) { const int r = L & 63; tile = sb * 4 + ((r & 31) >> 3); pn = (r >> 5) * 8 + (r & 7); }
        }
        const int e = te[tile];
        const int mt = tile - tp[e];
        u.a = gateup ? 0u : ((unsigned)e * CAP + (unsigned)mt * BM) * (unsigned)(DFF * MOE_ES);
        const unsigned wb = (unsigned)e * wstride;
        if (gateup) { u.b0 = wb + (unsigned)pn * HALF * 16; u.b1 = wb + (unsigned)(2048 + pn * HALF) * 16; }
        else { u.b0 = wb + (unsigned)pn * BM * 16; u.b1 = u.b0 + HALF * 16; }
        u.row0 = mt * BM; u.pn = pn; u.e = e; u.cnt = cn[e]; return true;
    }
};
}

struct Frame {
    LAS unsigned char* lds;
    unsigned* ctl;
    int tid, lane, wave, vcu, G;
    const float *x, *c, *norm1_g, *w_mod, *b_mod, *w_in, *conv_w, *w_out, *norm2_g, *w_router, *b_router, *w_gu, *b_gu, *w_dn, *b_dn, *final_g;
    float* out; unsigned char* ws;
};

template <int ES>
__device__ __forceinline__ void conv_item(const float* __restrict__ src, int N, unsigned char* __restrict__ dst, int kg, int nb, int lane, float scale) {
    constexpr int GK = 16 / ES;
    const int n0 = nb * 256 + lane * 4;
    const float* s = src + (size_t)kg * GK * N + n0;
    f32x4 v[GK];
#pragma unroll
    for (int r = 0; r < GK; ++r) v[r] = __builtin_nontemporal_load((const f32x4*)(s + (size_t)r * N));
    v4u* d = (v4u*)(dst + ((size_t)kg * N + n0) * 16);
#pragma unroll
    for (int j = 0; j < 4; ++j) {
        v4u o;
        if constexpr (ES == 2) { o.x = cvt_pk_bf16(v[0][j], v[1][j]); o.y = cvt_pk_bf16(v[2][j], v[3][j]); o.z = cvt_pk_bf16(v[4][j], v[5][j]); o.w = cvt_pk_bf16(v[6][j], v[7][j]); }
        else { o.x = pk4_fp8(v[0][j] * scale, v[1][j] * scale, v[2][j] * scale, v[3][j] * scale); o.y = pk4_fp8(v[4][j] * scale, v[5][j] * scale, v[6][j] * scale, v[7][j] * scale);
               o.z = pk4_fp8(v[8 % GK][j] * scale, v[9 % GK][j] * scale, v[10 % GK][j] * scale, v[11 % GK][j] * scale); o.w = pk4_fp8(v[12 % GK][j] * scale, v[13 % GK][j] * scale, v[14 % GK][j] * scale, v[15 % GK][j] * scale); }
        d[j] = o;
    }
}
template <int ES>
__device__ __forceinline__ void conv_matrix(Frame& F, const float* src, int K, int N, unsigned char* dst, int nmat, float scale) {
    constexpr int GK = 16 / ES;
    const int gw = F.vcu * NWAVES + F.wave, NGW = F.G * NWAVES;
    const int nnb = N / 256, per = (K / GK) * nnb; const long total = (long)per * nmat;
    for (long it = gw; it < total; it += NGW) {
        const int mat = (int)(it / per), r = (int)(it - (long)mat * per), kg = r / nnb, nb = r - kg * nnb;
        conv_item<ES>(src + (size_t)mat * K * N, N, dst + (size_t)mat * K * N * ES, kg, nb, F.lane, scale);
    }
}
__device__ __forceinline__ void p0_prologue(Frame& F) {
    if (F.vcu < 192) {
        LAS float* sc = (LAS float*)F.lds;
        LAS float* red = (LAS float*)(F.lds + 16384);
        const int c4 = F.tid & 15, kq = F.tid >> 4, col = F.vcu * 64 + c4 * 4;
        f32x4 wp[8];
#pragma unroll
        for (int j = 0; j < 8; ++j) wp[j] = __builtin_nontemporal_load((const f32x4*)(F.w_mod + (size_t)(kq + 32 * j) * 12288 + col));
        for (int i = F.tid; i < 4096; i += 512) { const float v = F.c[i]; sc[i] = v / (1.0f + __expf(-v)); }
        __syncthreads();
        f32x4 a0 = {0.f, 0.f, 0.f, 0.f}, a1 = {0.f, 0.f, 0.f, 0.f};
#pragma unroll
        for (int j = 0; j < 8; ++j) { a0 += wp[j] * sc[kq + 32 * j]; a1 += wp[j] * sc[2048 + kq + 32 * j]; }
#pragma unroll 8
        for (int k = kq + 256; k < DM; k += 32) { const f32x4 w = __builtin_nontemporal_load((const f32x4*)(F.w_mod + (size_t)k * 12288 + col)); a0 += w * sc[k]; a1 += w * sc[2048 + k]; }
#pragma unroll
        for (int j = 0; j < 4; ++j) { red[(kq * 2 + 0) * 64 + c4 * 4 + j] = a0[j]; red[(kq * 2 + 1) * 64 + c4 * 4 + j] = a1[j]; }
        __syncthreads();
        if (F.tid < 128) { const int b = F.tid >> 6, cc = F.tid & 63; float s = 0.f;
#pragma unroll 8
            for (int q = 0; q < 32; ++q) s += red[(q * 2 + b) * 64 + cc];
            ((float*)(F.ws + WS_MOD))[b * 12288 + F.vcu * 64 + cc] = s + F.b_mod[F.vcu * 64 + cc]; }
        __syncthreads();
    }
    {
        bf16* wrt = (bf16*)(F.ws + WS_WRT);
        for (int idx = F.vcu * 32 + F.tid; F.tid < 32 && idx < NEXP * (DM / 8); idx += F.G * 32) {
            const int e = idx & 31, k8 = idx >> 5; float v[8];
#pragma unroll
            for (int j = 0; j < 8; ++j) v[j] = F.w_router[(size_t)(k8 * 8 + j) * NEXP + e];
            v4u o; o.x = cvt_pk_bf16(v[0], v[1]); o.y = cvt_pk_bf16(v[2], v[3]); o.z = cvt_pk_bf16(v[4], v[5]); o.w = cvt_pk_bf16(v[6], v[7]);
            *(v4u*)(wrt + (size_t)e * DM + k8 * 8) = o;
        }
    }
    conv_matrix<2>(F, F.w_in, DM, NPROJ, F.ws + WS_WIN, 1, 1.0f);
    conv_matrix<OUT_FP8 ? 1 : 2>(F, F.w_out, DM, DM, F.ws + WS_WOUT, 1, 64.0f);
}
constexpr int CV_KG = DM / MOE_G;
constexpr int CV_ITEMS_GU = NEXP * CV_KG * 16, CV_ITEMS_DN = NEXP * CV_KG * 8;
constexpr int CV_PER_CHUNK = 16, CV_NCHUNK_GU = CV_ITEMS_GU / CV_PER_CHUNK, CV_NCHUNK_DN = CV_ITEMS_DN / CV_PER_CHUNK;
struct ConvRegs { f32x4 v[2][16 / MOE_ES]; unsigned char* d[2]; };
__device__ __forceinline__ void conv_chunk_load(Frame& F, int chunk, bool dn, ConvRegs& R) {
    constexpr int GK = 16 / MOE_ES;
#pragma unroll
    for (int i = 0; i < 2; ++i) {
        const int it = chunk * CV_PER_CHUNK + F.wave * 2 + i;
        const float* src; int N, kg, nb; unsigned char* dst;
        if (!dn) { const int per = CV_KG * 16, mq = it / per, r = it - mq * per, mat = NEXP - 1 - mq; kg = r >> 4; nb = r & 15; N = 2 * DFF;
            src = F.w_gu + (size_t)mat * DM * 2 * DFF; dst = F.ws + WS_WGU + (size_t)mat * DM * 2 * DFF * MOE_ES; }
        else { const int per = CV_KG * 8, mq = it / per, r = it - mq * per, mat = NEXP - 1 - mq; kg = r >> 3; nb = r & 7; N = DM;
            src = F.w_dn + (size_t)mat * DFF * DM; dst = F.ws + WS_WDN + (size_t)mat * DFF * DM * MOE_ES; }
        const int n0 = nb * 256 + F.lane * 4;
        const float* sp = src + (size_t)kg * GK * N + n0;
#pragma unroll
        for (int r = 0; r < GK; ++r) R.v[i][r] = __builtin_nontemporal_load((const f32x4*)(sp + (size_t)r * N));
        R.d[i] = dst + ((size_t)kg * N + n0) * 16;
    }
}
__device__ __forceinline__ void conv_chunk_finish(const Frame& F, ConvRegs& R) {
    constexpr int GK = 16 / MOE_ES; const float scale = 64.0f;
    LAS unsigned char* scr = F.lds + F.wave * 8192;
#pragma unroll
    for (int i = 0; i < 2; ++i) {
        LAS v4u* sw = (LAS v4u*)(scr + i * 4096);
#pragma unroll
        for (int j = 0; j < 4; ++j) {
            v4u o; const f32x4* v = R.v[i];
            if constexpr (MOE_ES == 2) { o.x = cvt_pk_bf16(v[0][j], v[1][j]); o.y = cvt_pk_bf16(v[2][j], v[3][j]); o.z = cvt_pk_bf16(v[4][j], v[5][j]); o.w = cvt_pk_bf16(v[6][j], v[7][j]); }
            else { o.x = pk4_fp8(v[0][j] * scale, v[1][j] * scale, v[2][j] * scale, v[3][j] * scale); o.y = pk4_fp8(v[4][j] * scale, v[5][j] * scale, v[6][j] * scale, v[7][j] * scale);
                   o.z = pk4_fp8(v[8 % GK][j] * scale, v[9 % GK][j] * scale, v[10 % GK][j] * scale, v[11 % GK][j] * scale); o.w = pk4_fp8(v[12 % GK][j] * scale, v[13 % GK][j] * scale, v[14 % GK][j] * scale, v[15 % GK][j] * scale); }
            sw[4 * F.lane + j] = o;
        }
    }
    LDS_WAIT();
#pragma unroll
    for (int i = 0; i < 2; ++i) {
        const LAS v4u* sr = (const LAS v4u*)(scr + i * 4096);
        const __amdgpu_buffer_rsrc_t rsw = __builtin_amdgcn_make_buffer_rsrc((void*)F.ws, 0, 0xfffffff0, 0x00020000);
        const unsigned ob = (unsigned)((R.d[i] - (size_t)F.lane * 64) - F.ws);
#pragma unroll
        for (int j = 0; j < 4; ++j) __builtin_amdgcn_raw_buffer_store_b128(sr[64 * j + F.lane], rsw, (int)(ob + (64 * j + F.lane) * 16), 0, CONV_ST_AUX);
    }
    LDS_WAIT();
}
__device__ __forceinline__ int conv_pop(Frame& F, LAS int* slot, bool dn, unsigned* done_word, unsigned done_target) {
    const int nch = dn ? CV_NCHUNK_DN : CV_NCHUNK_GU;
    if (F.tid == 0) { int c = nch;
        const bool stop = done_word && __hip_atomic_load(done_word, __ATOMIC_RELAXED, __HIP_MEMORY_SCOPE_AGENT) >= done_target;
        if (!stop) c = (int)__hip_atomic_fetch_add(F.ctl + (dn ? CW_CHEAD_DN : CW_CHEAD), 1u, __ATOMIC_RELAXED, __HIP_MEMORY_SCOPE_AGENT);
        *slot = c; }
    __syncthreads();
    const int c = *slot;
    __syncthreads();
    return c;
}
__device__ __forceinline__ void conv_pull(Frame& F, LAS int* slot, bool dn, unsigned* done_word, unsigned done_target) {
    const int nch = dn ? CV_NCHUNK_DN : CV_NCHUNK_GU;
    int c = conv_pop(F, slot, dn, done_word, done_target);
    while (c < nch) {
        ConvRegs R;
        conv_chunk_load(F, c, dn, R);
        const int cn = conv_pop(F, slot, dn, done_word, done_target);
        conv_chunk_finish(F, R);
        c = cn;
    }
}
__device__ __forceinline__ void conv_pull_cont(Frame& F, LAS int* slot, bool dn, ConvRegs& R) {
    const int nch = dn ? CV_NCHUNK_DN : CV_NCHUNK_GU;
    int c = conv_pop(F, slot, dn, nullptr, 0u);
    conv_chunk_finish(F, R);
    while (c < nch) {
        ConvRegs R2;
        conv_chunk_load(F, c, dn, R2);
        const int cn = conv_pop(F, slot, dn, nullptr, 0u);
        conv_chunk_finish(F, R2);
        c = cn;
    }
}
__device__ __forceinline__ void p1_consts(const Frame& F, int b, f32x4 (&A)[8], f32x4 (&B)[8]) {
    const float* mod = (const float*)(F.ws + WS_MOD);
    const f32x4* g = (const f32x4*)F.norm1_g + F.lane;
    const f32x4* sh = (const f32x4*)(mod + (size_t)b * 12288) + F.lane;
    const f32x4* scl = (const f32x4*)(mod + (size_t)b * 12288 + 2048) + F.lane;
    f32x4 gg[8], ss[8];
#pragma unroll
    for (int j = 0; j < 8; ++j) { gg[j] = g[64 * j]; ss[j] = scl[64 * j]; B[j] = sh[64 * j]; }
#pragma unroll
    for (int j = 0; j < 8; ++j) A[j] = gg[j] * (ss[j] + 1.0f);
}
__device__ __forceinline__ void p1_row(const Frame& F, int m, const f32x4 (&v)[8], const f32x4 (&A)[8], const f32x4 (&B)[8]) {
    bf16* H = (bf16*)(F.ws + WS_H);
    float s = 0.f;
#pragma unroll
    for (int j = 0; j < 8; ++j) s += (v[j].x * v[j].x + v[j].y * v[j].y) + (v[j].z * v[j].z + v[j].w * v[j].w);
    const float rstd = 1.0f / sqrtf(wave_sum(s) * (1.0f / DM) + EPS);
    v2u* o = (v2u*)(H + (size_t)m * DM) + F.lane;
#pragma unroll
    for (int j = 0; j < 8; ++j) { const f32x4 r = v[j] * rstd * A[j] + B[j];
        v2u w; w.x = cvt_pk_bf16(r.x, r.y); w.y = cvt_pk_bf16(r.z, r.w); o[64 * j] = w; }
}
__device__ __forceinline__ void p1_norm1(Frame& F) {
    const int gw = F.vcu * NWAVES + F.wave, NGW = F.G * NWAVES;
    f32x4 A[8], B[8]; int bc = -1;
    for (int m = gw; m < MTOK; m += 2 * NGW) {
        const int m2 = m + NGW; const bool two = m2 < MTOK;
        f32x4 v0[8], v1[8];
        { const f32x4* xr = (const f32x4*)(F.x + (size_t)m * DM) + F.lane;
#pragma unroll
          for (int j = 0; j < 8; ++j) v0[j] = __builtin_nontemporal_load(xr + 64 * j); }
        if (two) { const f32x4* xr = (const f32x4*)(F.x + (size_t)m2 * DM) + F.lane;
#pragma unroll
          for (int j = 0; j < 8; ++j) v1[j] = __builtin_nontemporal_load(xr + 64 * j); }
        if ((m >> 12) != bc) { bc = m >> 12; p1_consts(F, bc, A, B); }
        p1_row(F, m, v0, A, B);
        if (two) { if ((m2 >> 12) != bc) { bc = m2 >> 12; p1_consts(F, bc, A, B); } p1_row(F, m2, v1, A, B); }
    }
}

struct P3Ctx { const bf16* proj; bf16* LP; int b, h, bh, zg, t, dc, dblk, e0, r, hh; float g64, dk; float rfreq[8]; };
__device__ __forceinline__ void p3_load(const Frame& F, const P3Ctx& C, int z, v4u& k1, v4u& k2, v4u& v0, v4u& v1) {
    const size_t tok = (size_t)C.b * SEQ + (size_t)z * 64; const bf16* rp = C.proj + (tok + C.t) * NPROJ + C.h * HD;
    k1 = *(const v4u*)(rp + 1024 + C.dc * 8); k2 = *(const v4u*)(rp + 1024 + 64 + C.dc * 8);
    v0 = *(const v4u*)(C.proj + (tok + (F.tid >> 4)) * NPROJ + 2048 + C.h * HD + (F.tid & 15) * 8);
    v1 = *(const v4u*)(C.proj + (tok + 32 + (F.tid >> 4)) * NPROJ + 2048 + C.h * HD + (F.tid & 15) * 8);
}
__device__ __forceinline__ void p3_step(const Frame& F, const P3Ctx& C, int j, int buf, v4u& k1, v4u& k2, v4u& v0, v4u& v1, f32x16& acc0, f32x16& acc1) {
    constexpr int PITCH = 144, BUFB = 128 * PITCH;
    const int z = C.zg * 4 + j, pos = z * 64 + C.t, t = C.t, dc = C.dc, r = C.r, hh = C.hh;
    LAS unsigned char* KT = F.lds + buf * (2 * BUFB);
    LAS unsigned char* VT = KT + BUFB;
    {
        float cc[8], ss[8];
#pragma unroll
        for (int q = 0; q < 8; ++q) { const float rv = (float)pos * C.rfreq[q]; const float fr = rv - __builtin_floorf(rv); cc[q] = __builtin_amdgcn_cosf(fr); ss[q] = __builtin_amdgcn_sinf(fr); }
        const unsigned k1w[4] = {k1.x, k1.y, k1.z, k1.w}, k2w[4] = {k2.x, k2.y, k2.z, k2.w}, v0w[4] = {v0.x, v0.y, v0.z, v0.w}, v1w[4] = {v1.x, v1.y, v1.z, v1.w};
        const float dk = C.dk;
#pragma unroll
        for (int q = 0; q < 4; ++q) {
            const float a0 = bflo(k1w[q]), a1 = bfhi(k1w[q]), b0 = bflo(k2w[q]), b1 = bfhi(k2w[q]);
            const unsigned p1 = cvt_pk_bf16((a0 * cc[2 * q] - b0 * ss[2 * q]) * dk, (a1 * cc[2 * q + 1] - b1 * ss[2 * q + 1]) * dk);
            const unsigned p2 = cvt_pk_bf16((b0 * cc[2 * q] + a0 * ss[2 * q]) * dk, (b1 * cc[2 * q + 1] + a1 * ss[2 * q + 1]) * dk);
            const int kc = (((t >> 3) ^ dc) << 4) + ((t & 7) << 1);
            *(LAS unsigned short*)(KT + (dc * 8 + 2 * q) * PITCH + kc) = (unsigned short)(p1 & 0xffffu);
            *(LAS unsigned short*)(KT + (dc * 8 + 2 * q + 1) * PITCH + kc) = (unsigned short)(p1 >> 16);
            *(LAS unsigned short*)(KT + (64 + dc * 8 + 2 * q) * PITCH + kc) = (unsigned short)(p2 & 0xffffu);
            *(LAS unsigned short*)(KT + (64 + dc * 8 + 2 * q + 1) * PITCH + kc) = (unsigned short)(p2 >> 16);
            const int ec = F.tid & 15, tv = F.tid >> 4;
            const int vc0 = (((tv >> 3) ^ (ec & 7)) << 4) + ((tv & 7) << 1), vc1 = ((((32 + tv) >> 3) ^ (ec & 7)) << 4) + ((tv & 7) << 1);
            *(LAS unsigned short*)(VT + (ec * 8 + 2 * q) * PITCH + vc0) = (unsigned short)(v0w[q] & 0xffffu);
            *(LAS unsigned short*)(VT + (ec * 8 + 2 * q + 1) * PITCH + vc0) = (unsigned short)(v0w[q] >> 16);
            *(LAS unsigned short*)(VT + (ec * 8 + 2 * q) * PITCH + vc1) = (unsigned short)(v1w[q] & 0xffffu);
            *(LAS unsigned short*)(VT + (ec * 8 + 2 * q + 1) * PITCH + vc1) = (unsigned short)(v1w[q] >> 16);
        }
    }
    if (j + 2 < 4) p3_load(F, C, z + 2, k1, k2, v0, v1);
    {
        bf16* sp0 = C.LP + (((size_t)C.bh * NCHUNK + z) * HD + (C.e0 * 32 + 4 * hh)) * HD + C.dblk * 32 + r;
        bf16* sp1 = sp0 + (size_t)32 * HD;
#pragma unroll
        for (int i = 0; i < 16; i += 2) {
            const unsigned p0 = cvt_pk_bf16(acc0[i], acc0[i + 1]), p1 = cvt_pk_bf16(acc1[i], acc1[i + 1]);
            const int e_a = (i & 3) + 8 * (i >> 2), e_b = ((i + 1) & 3) + 8 * ((i + 1) >> 2);
            sp0[(size_t)e_a * HD] = (bf16)(p0 & 0xffffu); sp0[(size_t)e_b * HD] = (bf16)(p0 >> 16);
            sp1[(size_t)e_a * HD] = (bf16)(p1 & 0xffffu); sp1[(size_t)e_b * HD] = (bf16)(p1 >> 16);
        }
    }
    LDS_BARRIER();
#pragma unroll
    for (int i = 0; i < 16; ++i) { acc0[i] *= C.g64; acc1[i] *= C.g64; }
#pragma unroll
    for (int s = 0; s < 4; ++s) {
        const int sw = ((2 * s + hh) ^ ((r >> 3) & 3)) << 4;
        const bf16x8 af = *(const LAS bf16x8*)(KT + (C.dblk * 32 + r) * PITCH + (sw ^ ((C.dblk & 1) << 6)));
        const bf16x8 b0 = *(const LAS bf16x8*)(VT + (C.e0 * 32 + r) * PITCH + sw);
        const bf16x8 b1 = *(const LAS bf16x8*)(VT + ((C.e0 + 1) * 32 + r) * PITCH + (sw ^ 64));
        acc0 = __builtin_amdgcn_mfma_f32_32x32x16_bf16(b0, af, acc0, 0, 0, 0);
        acc1 = __builtin_amdgcn_mfma_f32_32x32x16_bf16(b1, af, acc1, 0, 0, 0);
    }
}
__device__ __forceinline__ void p3_scan_unit(Frame& F, int unit) {
    float* TT = (float*)(F.ws + WS_TT);
    P3Ctx C; C.proj = (const bf16*)(F.ws + WS_PROJ); C.LP = (bf16*)(F.ws + WS_ST);
    C.r = F.lane & 31; C.hh = F.lane >> 5; C.bh = unit >> 4; C.zg = unit & 15; C.b = C.bh >> 3; C.h = C.bh & 7;
    const float lg = lg2gamma(C.h); C.g64 = __builtin_amdgcn_exp2f(lg * 64.0f);
    C.t = F.tid >> 3; C.dc = F.tid & 7;
#pragma unroll
    for (int q = 0; q < 8; ++q) C.rfreq[q] = __builtin_amdgcn_exp2f(-(float)(C.dc * 8 + q) * (13.287712379549449f / 64.0f)) * 0.15915494309189535f;
    C.dk = __builtin_amdgcn_exp2f(lg * (float)(63 - C.t)) * 0.08838834764831845f;
    C.dblk = F.wave >> 1; C.e0 = (F.wave & 1) * 2;
    f32x16 acc0, acc1;
#pragma unroll
    for (int i = 0; i < 16; ++i) { acc0[i] = 0.f; acc1[i] = 0.f; }
    v4u ka1, ka2, va0, va1, kb1, kb2, vb0, vb1;
    p3_load(F, C, C.zg * 4, ka1, ka2, va0, va1);
    p3_load(F, C, C.zg * 4 + 1, kb1, kb2, vb0, vb1);
#pragma unroll 1
    for (int j = 0; j < 4; j += 2) {
        p3_step(F, C, j, 0, ka1, ka2, va0, va1, acc0, acc1);
        p3_step(F, C, j + 1, 1, kb1, kb2, vb0, vb1, acc0, acc1);
    }
    {
        float* tp0 = TT + (((size_t)C.bh * 16 + C.zg) * HD + (C.e0 * 32 + 4 * C.hh)) * HD + C.dblk * 32 + C.r;
        float* tp1 = tp0 + (size_t)32 * HD;
#pragma unroll
        for (int i = 0; i < 16; ++i) { const int e_i = (i & 3) + 8 * (i >> 2); tp0[(size_t)e_i * HD] = acc0[i]; tp1[(size_t)e_i * HD] = acc1[i]; }
    }
    LDS_BARRIER();
}
__device__ __forceinline__ void p3_conv_blocks(Frame& F, int blk_lo, int blk_hi, int blk_step) {
    const bf16* proj = (const bf16*)(F.ws + WS_PROJ);
    {
        bf16* Y = (bf16*)(F.ws + WS_Y);
        const int chc = F.tid & 127, tsub = F.tid >> 7, ch0 = chc * 8;
        float w0[8], w1[8], w2[8];
#pragma unroll
        for (int q = 0; q < 8; ++q) { w0[q] = F.conv_w[ch0 + q]; w1[q] = F.conv_w[1024 + ch0 + q]; w2[q] = F.conv_w[2048 + ch0 + q]; }
        for (int blk = blk_lo; blk < blk_hi; blk += blk_step) {
            const int t0 = blk * 32 + tsub * 8;
            float p1[8], p2[8];
#pragma unroll
            for (int q = 0; q < 8; ++q) { p1[q] = 0.f; p2[q] = 0.f; }
            v4u cgs[10], uus[10], bgs[8];
#pragma unroll
            for (int i = -2; i < 8; ++i) { const int t = t0 + i; const bool valid = ((t0 & (SEQ - 1)) + i) >= 0; const bf16* row = proj + (size_t)(valid ? t : t0) * NPROJ;
                cgs[i + 2] = *(const v4u*)(row + 5120 + ch0); uus[i + 2] = *(const v4u*)(row + 6144 + ch0);
                if (i >= 0) bgs[i] = *(const v4u*)(row + 4096 + ch0); }
#pragma unroll
            for (int i = -2; i < 8; ++i) {
                const int t = t0 + i; const bool valid = ((t0 & (SEQ - 1)) + i) >= 0;
                float p[8];
                if (valid) {
                    const v4u cg = cgs[i + 2], uu = uus[i + 2];
                    const unsigned cw[4] = {cg.x, cg.y, cg.z, cg.w}, uw[4] = {uu.x, uu.y, uu.z, uu.w};
#pragma unroll
                    for (int q = 0; q < 4; ++q) { p[2 * q] = bflo(cw[q]) * bflo(uw[q]); p[2 * q + 1] = bfhi(cw[q]) * bfhi(uw[q]); }
                } else {
#pragma unroll
                    for (int q = 0; q < 8; ++q) p[q] = 0.f;
                }
                if (i >= 0) {
                    const v4u bg = bgs[i];
                    const unsigned bw[4] = {bg.x, bg.y, bg.z, bg.w}; float o[8];
#pragma unroll
                    for (int q = 0; q < 4; ++q) {
                        o[2 * q] = bflo(bw[q]) * (w0[2 * q] * p2[2 * q] + w1[2 * q] * p1[2 * q] + w2[2 * q] * p[2 * q]);
                        o[2 * q + 1] = bfhi(bw[q]) * (w0[2 * q + 1] * p2[2 * q + 1] + w1[2 * q + 1] * p1[2 * q + 1] + w2[2 * q + 1] * p[2 * q + 1]);
                    }
                    if constexpr (OUT_FP8) { v2u ov; ov.x = pk4_fp8(o[0], o[1], o[2], o[3]); ov.y = pk4_fp8(o[4], o[5], o[6], o[7]); *(v2u*)((unsigned char*)Y + (size_t)t * DM + 1024 + ch0) = ov; }
                    else { v4u ov; ov.x = cvt_pk_bf16(o[0], o[1]); ov.y = cvt_pk_bf16(o[2], o[3]); ov.z = cvt_pk_bf16(o[4], o[5]); ov.w = cvt_pk_bf16(o[6], o[7]);
                    *(v4u*)(Y + (size_t)t * DM + 1024 + ch0) = ov; }
                }
#pragma unroll
                for (int q = 0; q < 8; ++q) { p2[q] = p1[q]; p1[q] = p[q]; }
            }
        }
    }
}

__device__ __forceinline__ void p3a_scan_conv(Frame& F) {
    for (int u = F.vcu; u < 256; u += F.G) p3_scan_unit(F, u);
    p3_conv_blocks(F, F.vcu, MTOK / 32, F.G);
}
__device__ __forceinline__ void p3b_carry(Frame& F) {
    const float* TT = (const float*)(F.ws + WS_TT); bf16* CR = (bf16*)(F.ws + WS_CARRY);
    for (int idx = F.vcu * 512 + F.tid; idx < 16 * 4096; idx += F.G * 512) {
        const int bh = idx >> 12, el = (idx & 4095) * 4;
        const float g512 = __builtin_amdgcn_exp2f(lg2gamma(bh & 7) * 256.0f);
        f32x4 c = {0.f, 0.f, 0.f, 0.f}, tt[15];
#pragma unroll
        for (int zg = 0; zg < 15; ++zg) tt[zg] = *(const f32x4*)(TT + ((size_t)bh * 16 + zg) * (HD * HD) + el);
#pragma unroll
        for (int zg = 0; zg < 15; ++zg) {
            c = c * g512 + tt[zg];
            v2u o; o.x = cvt_pk_bf16(c.x, c.y); o.y = cvt_pk_bf16(c.z, c.w);
            *(v2u*)(CR + ((size_t)bh * 16 + zg + 1) * (HD * HD) + el) = o;
        }
    }
}

struct P4Regs { v4u q1, q2, k1, k2, v0, v1; };
__device__ __forceinline__ void p4_load(const Frame& F, const bf16* proj, int unit, P4Regs& R) {
    const int bh = unit >> 6, z = unit & 63, b = bh >> 3, h = bh & 7;
    const size_t tok0 = (size_t)b * SEQ + z * 64;
    const int t = F.tid >> 3, dc = F.tid & 7;
    const bf16* rowp = proj + (tok0 + t) * NPROJ + h * HD;
    R.q1 = *(const v4u*)(rowp + dc * 8); R.q2 = *(const v4u*)(rowp + 64 + dc * 8);
    R.k1 = *(const v4u*)(rowp + 1024 + dc * 8); R.k2 = *(const v4u*)(rowp + 1024 + 64 + dc * 8);
    R.v0 = *(const v4u*)(proj + (tok0 + (F.tid >> 4)) * NPROJ + 2048 + h * HD + (F.tid & 15) * 8);
    R.v1 = *(const v4u*)(proj + (tok0 + 32 + (F.tid >> 4)) * NPROJ + 2048 + h * HD + (F.tid & 15) * 8);
}
__device__ __forceinline__ void p4_retention(Frame& F) {
    const bf16* proj = (const bf16*)(F.ws + WS_PROJ);
    const bf16* ST = (const bf16*)(F.ws + WS_ST);
    float rfreq[8];
#pragma unroll
    for (int q = 0; q < 8; ++q) rfreq[q] = __builtin_amdgcn_exp2f(-(float)((F.tid & 7) * 8 + q) * (13.287712379549449f / 64.0f)) * 0.15915494309189535f;
    bf16* Y = (bf16*)(F.ws + WS_Y);
    constexpr int QP = 272, VP = 144;
    LAS unsigned char* QL = F.lds;
    LAS unsigned char* KL = F.lds + 17408;
    LAS unsigned char* VT = F.lds + 34816;
    LAS float* STAT = (LAS float*)(F.lds + 53248);
    const int lane = F.lane, w = F.wave, r = lane & 31, hh = lane >> 5, rh = w >> 2, cq = w & 3;
    P4Regs R;
    if (F.vcu < 1024) p4_load(F, proj, F.vcu, R);
    for (int unit = F.vcu; unit < 1024; unit += F.G) {
        const int bh = unit >> 6, z = unit & 63, b = bh >> 3, h = bh & 7;
        const float lg = lg2gamma(h);
        const size_t tok0 = (size_t)b * SEQ + z * 64;
        bf16x8 sf[8]; v4u cf[8];
        {
            const bf16* sp = ST + (((size_t)bh * NCHUNK + z) * HD + 32 * cq + r) * HD + 8 * hh;
            const bf16* cp = (const bf16*)(F.ws + WS_CARRY) + (((size_t)bh * 16 + (z >= 4 ? (z >> 2) : 1)) * HD + 32 * cq + r) * HD + 8 * hh;
#pragma unroll
            for (int s = 0; s < 8; ++s) { sf[s] = *(const bf16x8*)(sp + 16 * s); cf[s] = *(const v4u*)(cp + 16 * s); }
        }
        {
            const int t = F.tid >> 3, dc = F.tid & 7, pos = z * 64 + t;
            float cc[8], ss[8];
#pragma unroll
            for (int q = 0; q < 8; ++q) { const float rv = (float)pos * rfreq[q]; const float fr = rv - __builtin_floorf(rv); cc[q] = __builtin_amdgcn_cosf(fr); ss[q] = __builtin_amdgcn_sinf(fr); }
            const unsigned q1w[4] = {R.q1.x, R.q1.y, R.q1.z, R.q1.w}, q2w[4] = {R.q2.x, R.q2.y, R.q2.z, R.q2.w}, k1w[4] = {R.k1.x, R.k1.y, R.k1.z, R.k1.w}, k2w[4] = {R.k2.x, R.k2.y, R.k2.z, R.k2.w};
            unsigned qap[4], qbp[4], kap[4], kbp[4];
            const float ksc = 0.08838834764831845f;
#pragma unroll
            for (int q = 0; q < 4; ++q) {
                const float a0 = bflo(q1w[q]), a1 = bfhi(q1w[q]), b0 = bflo(q2w[q]), b1 = bfhi(q2w[q]);
                qap[q] = cvt_pk_bf16(a0 * cc[2 * q] - b0 * ss[2 * q], a1 * cc[2 * q + 1] - b1 * ss[2 * q + 1]);
                qbp[q] = cvt_pk_bf16(b0 * cc[2 * q] + a0 * ss[2 * q], b1 * cc[2 * q + 1] + a1 * ss[2 * q + 1]);
                const float e0 = bflo(k1w[q]), e1 = bfhi(k1w[q]), f0 = bflo(k2w[q]), f1 = bfhi(k2w[q]);
                kap[q] = cvt_pk_bf16((e0 * cc[2 * q] - f0 * ss[2 * q]) * ksc, (e1 * cc[2 * q + 1] - f1 * ss[2 * q + 1]) * ksc);
                kbp[q] = cvt_pk_bf16((f0 * cc[2 * q] + e0 * ss[2 * q]) * ksc, (f1 * cc[2 * q + 1] + e1 * ss[2 * q + 1]) * ksc);
            }
            *(LAS v4u*)(QL + t * QP + dc * 16) = (v4u){qap[0], qap[1], qap[2], qap[3]}; *(LAS v4u*)(QL + t * QP + 128 + dc * 16) = (v4u){qbp[0], qbp[1], qbp[2], qbp[3]};
            *(LAS v4u*)(KL + t * QP + dc * 16) = (v4u){kap[0], kap[1], kap[2], kap[3]}; *(LAS v4u*)(KL + t * QP + 128 + dc * 16) = (v4u){kbp[0], kbp[1], kbp[2], kbp[3]};
            const unsigned v0w[4] = {R.v0.x, R.v0.y, R.v0.z, R.v0.w}, v1w[4] = {R.v1.x, R.v1.y, R.v1.z, R.v1.w};
            const int ec = F.tid & 15, tv = F.tid >> 4;
            const int vc0 = (((tv >> 3) ^ (ec & 7)) << 4) + ((tv & 7) << 1), vc1 = ((((32 + tv) >> 3) ^ (ec & 7)) << 4) + ((tv & 7) << 1);
#pragma unroll
            for (int q = 0; q < 4; ++q) {
                *(LAS unsigned short*)(VT + (ec * 8 + 2 * q) * VP + vc0) = (unsigned short)(v0w[q] & 0xffffu);
                *(LAS unsigned short*)(VT + (ec * 8 + 2 * q + 1) * VP + vc0) = (unsigned short)(v0w[q] >> 16);
                *(LAS unsigned short*)(VT + (ec * 8 + 2 * q) * VP + vc1) = (unsigned short)(v1w[q] & 0xffffu);
                *(LAS unsigned short*)(VT + (ec * 8 + 2 * q + 1) * VP + vc1) = (unsigned short)(v1w[q] >> 16);
            }
        }
        v4u gv[2];
#pragma unroll
        for (int i = 0; i < 2; ++i) { const int idx = F.tid + 512 * i; gv[i] = *(const v4u*)(proj + (tok0 + (idx >> 4)) * NPROJ + 3072 + h * HD + (idx & 15) * 8); }
        if (unit + F.G < 1024) p4_load(F, proj, unit + F.G, R);
        LDS_BARRIER();
        if (z >= 4) {
            const float dec = __builtin_amdgcn_exp2f(lg * 64.0f * (float)(z & 3));
#pragma unroll
            for (int s = 0; s < 8; ++s) { const v4u cw = cf[s]; const v4u lw = __builtin_bit_cast(v4u, sf[s]); v4u o;
                o.x = cvt_pk_bf16(bflo(lw.x) + dec * bflo(cw.x), bfhi(lw.x) + dec * bfhi(cw.x)); o.y = cvt_pk_bf16(bflo(lw.y) + dec * bflo(cw.y), bfhi(lw.y) + dec * bfhi(cw.y));
                o.z = cvt_pk_bf16(bflo(lw.z) + dec * bflo(cw.z), bfhi(lw.z) + dec * bfhi(cw.z)); o.w = cvt_pk_bf16(bflo(lw.w) + dec * bflo(cw.w), bfhi(lw.w) + dec * bfhi(cw.w));
                sf[s] = __builtin_bit_cast(bf16x8, o); }
        }
        bf16x8 qf[8];
#pragma unroll
        for (int s = 0; s < 8; ++s) qf[s] = *(const LAS bf16x8*)(QL + (32 * rh + r) * QP + (16 * s + 8 * hh) * 2);
        f32x16 acc;
#pragma unroll
        for (int i = 0; i < 16; ++i) acc[i] = 0.f;
#pragma unroll
        for (int s = 0; s < 8; ++s) acc = __builtin_amdgcn_mfma_f32_32x32x16_bf16(sf[s], qf[s], acc, 0, 0, 0);
        const int qi = 32 * rh + r;
        { const float dq = __builtin_amdgcn_exp2f(lg * (float)(qi + 1));
#pragma unroll
          for (int i = 0; i < 16; ++i) acc[i] *= dq; }
#pragma unroll
        for (int kb = 0; kb < 2; ++kb) {
            f32x16 X;
#pragma unroll
            for (int i = 0; i < 16; ++i) X[i] = 0.f;
#pragma unroll
            for (int s = 0; s < 8; ++s) { const bf16x8 kf = *(const LAS bf16x8*)(KL + (32 * kb + r) * QP + (16 * s + 8 * hh) * 2);
                X = __builtin_amdgcn_mfma_f32_32x32x16_bf16(kf, qf[s], X, 0, 0, 0); }
#pragma unroll
            for (int i = 0; i < 16; ++i) { const int key = 32 * kb + (i & 3) + 8 * (i >> 2) + 4 * hh; const int dd = qi > key ? qi - key : key - qi;
                X[i] *= __builtin_amdgcn_exp2f(lg * (float)dd); }
#pragma unroll
            for (int s2 = 0; s2 < 2; ++s2) {
                v4u pw; pw.x = cvt_pk_bf16(X[8 * s2], X[8 * s2 + 1]); pw.y = cvt_pk_bf16(X[8 * s2 + 2], X[8 * s2 + 3]); pw.z = cvt_pk_bf16(X[8 * s2 + 4], X[8 * s2 + 5]); pw.w = cvt_pk_bf16(X[8 * s2 + 6], X[8 * s2 + 7]);
                const bf16x8 pf = __builtin_bit_cast(bf16x8, pw);
                const int rsw = 4 * (cq & 1) + (r >> 3);
                const LAS unsigned char* vrow = VT + (32 * cq + r) * VP + 8 * hh;
                const v2u va = *(const LAS v2u*)(vrow + (((4 * kb + 2 * s2) ^ rsw) << 4)), vb = *(const LAS v2u*)(vrow + (((4 * kb + 2 * s2 + 1) ^ rsw) << 4));
                v4u vw; vw.x = va.x; vw.y = va.y; vw.z = vb.x; vw.w = vb.y;
                acc = __builtin_amdgcn_mfma_f32_32x32x16_bf16(__builtin_bit_cast(bf16x8, vw), pf, acc, 0, 0, 0);
            }
        }
        float s1 = 0.f, s2 = 0.f;
#pragma unroll
        for (int i = 0; i < 16; ++i) { s1 += acc[i]; s2 += acc[i] * acc[i]; }
        s1 += __shfl_xor(s1, 32); s2 += __shfl_xor(s2, 32);
        if (hh == 0) { STAT[((rh * 4 + cq) * 32 + r) * 2] = s1; STAT[((rh * 4 + cq) * 32 + r) * 2 + 1] = s2; }
        LDS_BARRIER();
        float t1 = 0.f, t2 = 0.f;
#pragma unroll
        for (int c = 0; c < 4; ++c) { t1 += STAT[((rh * 4 + c) * 32 + r) * 2]; t2 += STAT[((rh * 4 + c) * 32 + r) * 2 + 1]; }
        const float mu = t1 * (1.0f / HD), var = fmaxf(t2 * (1.0f / HD) - mu * mu, 0.f), rstd = 1.0f / sqrtf(var + EPS);
#pragma unroll
        for (int g = 0; g < 4; ++g) {
            v2u o; o.x = cvt_pk_bf16((acc[4 * g] - mu) * rstd, (acc[4 * g + 1] - mu) * rstd); o.y = cvt_pk_bf16((acc[4 * g + 2] - mu) * rstd, (acc[4 * g + 3] - mu) * rstd);
            *(LAS v2u*)(QL + qi * QP + (32 * cq + 8 * g + 4 * hh) * 2) = o;
        }
        LDS_BARRIER();
#pragma unroll
        for (int i = 0; i < 2; ++i) {
            const int idx = F.tid + 512 * i, t = idx >> 4, ec = idx & 15;
            const v4u ov = *(const LAS v4u*)(QL + t * QP + ec * 16);
            const unsigned ow[4] = {ov.x, ov.y, ov.z, ov.w}, gw[4] = {gv[i].x, gv[i].y, gv[i].z, gv[i].w}; unsigned rw[4];
            float yy[8];
#pragma unroll
            for (int q = 0; q < 4; ++q) { const float g0 = bflo(gw[q]), g1 = bfhi(gw[q]);
                const float y0 = g0 / (1.0f + __expf(-g0)) * bflo(ow[q]), y1 = g1 / (1.0f + __expf(-g1)) * bfhi(ow[q]);
                yy[2 * q] = y0; yy[2 * q + 1] = y1; rw[q] = cvt_pk_bf16(y0, y1); }
            if constexpr (OUT_FP8) { v2u yv; yv.x = pk4_fp8(yy[0], yy[1], yy[2], yy[3]); yv.y = pk4_fp8(yy[4], yy[5], yy[6], yy[7]); *(v2u*)((unsigned char*)Y + (tok0 + t) * DM + h * HD + ec * 8) = yv; }
            else { v4u yv; yv.x = rw[0]; yv.y = rw[1]; yv.z = rw[2]; yv.w = rw[3];
            *(v4u*)(Y + (tok0 + t) * DM + h * HD + ec * 8) = yv; }
        }
        LDS_BARRIER();
    }
}

struct P6Row { f32x4 x[8]; v2u d[8]; };
__device__ __forceinline__ void p6_load(const Frame& F, int m, P6Row& R) {
    const f32x4* xr = (const f32x4*)(F.x + (size_t)m * DM) + F.lane;
    const v2u* dr = (const v2u*)((const bf16*)(F.ws + WS_X1) + (size_t)m * DM) + F.lane;
#pragma unroll
    for (int j = 0; j < 8; ++j) { R.x[j] = __builtin_nontemporal_load(xr + 64 * j); R.d[j] = dr[64 * j]; }
}
__device__ __forceinline__ void p6_norm(const Frame& F, int m, int tl, const P6Row& R, LAS unsigned char* H2) {
    constexpr int HP = 4112;
    const float* mod = (const float*)(F.ws + WS_MOD);
    unsigned char* H2G = F.ws + WS_H; const int b = m >> 12, lane = F.lane;
    f32x4 v[8]; float s = 0.f;
#pragma unroll
    for (int j = 0; j < 8; ++j) { const v2u dw = R.d[j]; v[j] = R.x[j] + (f32x4){bflo(dw.x), bfhi(dw.x), bflo(dw.y), bfhi(dw.y)}; s += (v[j].x * v[j].x + v[j].y * v[j].y) + (v[j].z * v[j].z + v[j].w * v[j].w); }
    {
        v2u* xo = (v2u*)((bf16*)(F.ws + WS_X1) + (size_t)m * DM) + lane;
#pragma unroll
        for (int j = 0; j < 8; ++j) { v2u wv; wv.x = cvt_pk_bf16(v[j].x, v[j].y); wv.y = cvt_pk_bf16(v[j].z, v[j].w); xo[64 * j] = wv; }
    }
    const float rstd = 1.0f / sqrtf(wave_sum(s) * (1.0f / DM) + EPS);
    const f32x4* g = (const f32x4*)F.norm2_g + lane;
    const f32x4* sh = (const f32x4*)(mod + (size_t)b * 12288 + 6144) + lane;
    const f32x4* scl = (const f32x4*)(mod + (size_t)b * 12288 + 8192) + lane;
    unsigned char* grow = H2G + (size_t)m * (DM * MOE_ES);
#pragma unroll
    for (int hj = 0; hj < 2; ++hj) {
        f32x4 cg[4], cs[4], ch[4];
#pragma unroll
        for (int jj = 0; jj < 4; ++jj) { const int j = 4 * hj + jj; cg[jj] = g[64 * j]; cs[jj] = scl[64 * j]; ch[jj] = sh[64 * j]; }
#pragma unroll
        for (int jj = 0; jj < 4; ++jj) { const int j = 4 * hj + jj;
            const f32x4 rr = v[j] * rstd * cg[jj] * (cs[jj] + 1.0f) + ch[jj];
            v2u wv; wv.x = cvt_pk_bf16(rr.x, rr.y); wv.y = cvt_pk_bf16(rr.z, rr.w);
            *(LAS v2u*)(H2 + tl * HP + (64 * j + lane) * 8) = wv;
            if constexpr (MOE_FP8) *((unsigned*)grow + 64 * j + lane) = pk4_fp8(rr.x, rr.y, rr.z, rr.w);
            else *((v2u*)grow + 64 * j + lane) = wv; }
    }
}
__device__ __forceinline__ void p6a_router(Frame& F) {
    const bf16* wrt = (const bf16*)(F.ws + WS_WRT);
    int* tke = (int*)(F.ws + WS_TKE); float* tkw = (float*)(F.ws + WS_TKW); int* hist = (int*)(F.ws + WS_HIST);
    constexpr int HP = 4112;
    LAS unsigned char* H2 = F.lds;
    LAS float* PL = (LAS float*)(F.lds + 65792);
    LAS int* HS = (LAS int*)(F.lds + 65792 + 16384);
    const int lane = F.lane, w = F.wave, fr = lane & 15, fq = lane >> 4;
    P6Row RA, RB;
    if (F.vcu < MTOK / 16) { p6_load(F, F.vcu * 16 + 2 * w, RA); p6_load(F, F.vcu * 16 + 2 * w + 1, RB); }
    for (int unit = F.vcu; unit < MTOK / 16; unit += F.G) {
        const int tok0 = unit * 16; const bool more = unit + F.G < MTOK / 16; const int ntok0 = (unit + F.G) * 16;
        if (F.tid < 32) HS[F.tid] = 0;
        p6_norm(F, tok0 + 2 * w, 2 * w, RA, H2);
        if (more) p6_load(F, ntok0 + 2 * w, RA);
        p6_norm(F, tok0 + 2 * w + 1, 2 * w + 1, RB, H2);
        if (more) p6_load(F, ntok0 + 2 * w + 1, RB);
        bf16x8 wb0[8], wb1[8];
#pragma unroll
        for (int s = 0; s < 8; ++s) { const int k0 = 256 * w + 32 * s + 8 * fq; wb0[s] = *(const bf16x8*)(wrt + (size_t)fr * DM + k0); wb1[s] = *(const bf16x8*)(wrt + (size_t)(16 + fr) * DM + k0); }
        LDS_BARRIER();
        {
            f32x4 a0 = {0.f, 0.f, 0.f, 0.f}, a1 = {0.f, 0.f, 0.f, 0.f};
#pragma unroll
            for (int s = 0; s < 8; ++s) {
                const int k0 = 256 * w + 32 * s + 8 * fq;
                const bf16x8 af = *(const LAS bf16x8*)(H2 + fr * HP + k0 * 2);
                a0 = __builtin_amdgcn_mfma_f32_16x16x32_bf16(af, wb0[s], a0, 0, 0, 0);
                a1 = __builtin_amdgcn_mfma_f32_16x16x32_bf16(af, wb1[s], a1, 0, 0, 0);
            }
#pragma unroll
            for (int j = 0; j < 4; ++j) { PL[(w * 16 + 4 * fq + j) * 32 + fr] = a0[j]; PL[(w * 16 + 4 * fq + j) * 32 + 16 + fr] = a1[j]; }
        }
        LDS_BARRIER();
        {
            const int tl = F.tid >> 5, e = F.tid & 31; float cur = F.b_router[e];
#pragma unroll
            for (int q = 0; q < 8; ++q) cur += PL[(q * 16 + tl) * 32 + e];
            float tv[4]; int ti[4];
#pragma unroll
            for (int k = 0; k < 4; ++k) {
                float bv = cur; int bi = e;
#pragma unroll
                for (int o = 16; o > 0; o >>= 1) { const float ov = __shfl_xor(bv, o, 32); const int oi = __shfl_xor(bi, o, 32);
                    const bool take = (ov > bv) || (ov == bv && oi < bi); bv = take ? ov : bv; bi = take ? oi : bi; }
                tv[k] = bv; ti[k] = bi; if (e == bi) cur = -__builtin_inff();
            }
            float ex[4], sum = 0.f;
#pragma unroll
            for (int k = 0; k < 4; ++k) { ex[k] = __expf(tv[k] - tv[0]); sum += ex[k]; }
            const float inv = 1.0f / sum;
            if (e < 4) {
                const int me = e == 0 ? ti[0] : e == 1 ? ti[1] : e == 2 ? ti[2] : ti[3];
                const float mw = (e == 0 ? ex[0] : e == 1 ? ex[1] : e == 2 ? ex[2] : ex[3]) * inv;
                tke[(tok0 + tl) * 4 + e] = me; tkw[(tok0 + tl) * 4 + e] = mw;
                __hip_atomic_fetch_add(HS + me, 1, __ATOMIC_RELAXED, __HIP_MEMORY_SCOPE_WORKGROUP);
            }
        }
        LDS_BARRIER();
        if (F.tid < 32) hist[unit * 32 + F.tid] = HS[F.tid];
        LDS_BARRIER();
    }
}
__device__ __forceinline__ void p6b_dispatch(Frame& F) {
    const int* tke = (const int*)(F.ws + WS_TKE); const float* tkw = (const float*)(F.ws + WS_TKW); const int* hist = (const int*)(F.ws + WS_HIST);
    int* dest = (int*)(F.ws + WS_DEST); float* wrow = (float*)(F.ws + WS_WROW);
    LAS int* PART = (LAS int*)F.lds;
    LAS int* OFF = PART + 512;
    LAS int* EL = OFF + 32;
    LAS int* SL = EL + 64;
    constexpr int NUNIT = MTOK / 16;
    LAS int* OFFU = SL + 128;
    LAS float* WL = (LAS float*)(OFFU + 64);
    LAS int* EL2 = (LAS int*)(WL + 128);
    const bool fast = (F.G == 256);
    LAS int* cslot = (LAS int*)(F.lds + LDSCTL_OFF + 768);
    ConvRegs R0; const int c0 = conv_pop(F, cslot, false, nullptr, 0u); const bool have0 = c0 < CV_NCHUNK_GU;
    if (have0) conv_chunk_load(F, c0, false, R0);
    if (fast && F.tid >= 128 && F.tid < 256) { const int k = (F.tid - 128) >> 6, j = F.tid & 63, un = F.vcu + k * 256;
        EL2[k * 64 + j] = tke[un * 64 + j]; WL[k * 64 + j] = tkw[un * 64 + j]; }
    { const int e = F.tid & 31, p = F.tid >> 5; int s = 0; const int u1 = F.vcu, u2 = F.vcu + 256;
      int hv[32];
#pragma unroll
      for (int i = 0; i < 32; ++i) hv[i] = hist[(32 * p + i) * 32 + e];
#pragma unroll
      for (int i = 0; i < 32; ++i) { const int u = 32 * p + i; if (u == u1) OFFU[e] = s; if (u == u2) OFFU[32 + e] = s; s += hv[i]; }
      PART[p * 32 + e] = s; }
    __syncthreads();
    if (F.vcu == 0 && F.tid < 32) { int t = 0;
#pragma unroll
        for (int p = 0; p < 16; ++p) t += PART[p * 32 + F.tid];
        F.ctl[CW_CNT + F.tid] = (unsigned)t; }
    if (F.tid < 64) {
        LAS int* tp = (LAS int*)(F.lds + LDSCTL_OFF + 448); LAS int* cn = tp + 40;
        const int e = F.tid & 31; int c = 0;
#pragma unroll
        for (int p = 0; p < 16; ++p) c += PART[p * 32 + e];
        int incl = (c + 255) >> 8;
#pragma unroll
        for (int o = 1; o < 32; o <<= 1) { const int n = __shfl_up(incl, o); if ((F.tid & 31) >= o) incl += n; }
        if (F.tid < 32) { cn[e] = c; tp[e + 1] = incl; if (e == 0) tp[0] = 0; }
    }
    __syncthreads();
    if (F.tid >= 256) { const int tl = F.tid - 256; LAS int* tp = (LAS int*)(F.lds + LDSCTL_OFF + 448); int e = 0;
#pragma unroll 1
        for (int s = 16; s > 0; s >>= 1) if (tp[e + s] <= tl) e += s;
        ((LAS int*)(F.lds + LDSCTL_OFF + 8192))[tl] = e; }
    for (int unit = F.vcu, k = 0; unit < NUNIT; unit += F.G, ++k) {
        if (F.tid < 32) { int s = 0; const int pg = unit >> 5;
            for (int p = 0; p < pg; ++p) s += PART[p * 32 + F.tid];
            if (fast) s += OFFU[k * 32 + F.tid];
            else for (int u = pg * 32; u < unit; ++u) s += hist[u * 32 + F.tid];
            OFF[F.tid] = s; }
        if (F.tid >= 64 && F.tid < 128) EL[F.tid - 64] = fast ? EL2[k * 64 + F.tid - 64] : tke[unit * 64 + F.tid - 64];
        __syncthreads();
        if (F.tid < 64) { const int ei = EL[F.tid]; int rank = 0;
            const unsigned long long below = (1ull << F.tid) - 1ull;
#pragma unroll 4
            for (int e = 0; e < NEXP; ++e) { const unsigned long long mk = __ballot(ei == e); if (ei == e) rank = __popcll(mk & below); }
            const int slot = OFF[ei] + rank;
            dest[(size_t)ei * CAP + slot] = unit * 64 + F.tid; wrow[(size_t)ei * CAP + slot] = fast ? WL[k * 64 + F.tid] : tkw[unit * 64 + F.tid];
            SL[F.tid * 2] = ei; SL[F.tid * 2 + 1] = slot; }
        __syncthreads();
    }
    if (have0) conv_pull_cont(F, cslot, false, R0);
}

__device__ __forceinline__ void moe_table(Frame& F, LAS int* tp, LAS int* cn) {
    if (F.tid < 64) {
        const int e = F.tid & 31;
        const int c = (int)__hip_atomic_load(F.ctl + CW_CNT + e, __ATOMIC_RELAXED, __HIP_MEMORY_SCOPE_AGENT);
        const int tl = (c + 255) >> 8;
        int incl = tl;
#pragma unroll
        for (int o = 1; o < 32; o <<= 1) { const int n = __shfl_up(incl, o); if ((F.tid & 31) >= o) incl += n; }
        if (F.tid < 32) { cn[e] = c; tp[e + 1] = incl; if (e == 0) tp[0] = 0; }
    }
    __syncthreads();
    if (F.tid < 256) { int e = 0;
#pragma unroll 1
        for (int s = 16; s > 0; s >>= 1) if (tp[e + s] <= F.tid) e += s;
        ((LAS int*)(F.lds + LDSCTL_OFF + 8192))[F.tid] = e; }
    __syncthreads();
}

struct P9Row { unsigned cw[8][4]; v2u d[8]; };
__device__ __forceinline__ void p9_load(const Frame& F, int m, P9Row& R) {
    const unsigned char* CB = F.ws + WS_CONTRIB;
    const v2u* dr = (const v2u*)((const bf16*)(F.ws + WS_X1) + (size_t)m * DM) + F.lane;
#pragma unroll
    for (int j = 0; j < 8; ++j) {
#pragma unroll
        for (int k = 0; k < 4; ++k) R.cw[j][k] = __builtin_nontemporal_load((const unsigned*)(CB + ((size_t)m * 4 + k) * DM) + 64 * j + F.lane);
        R.d[j] = __builtin_nontemporal_load(dr + 64 * j);
    }
}
__device__ __forceinline__ void p9_gate(const Frame& F, int b, f32x4 (&g2)[8]) {
    const f32x4* gp = (const f32x4*)((const float*)(F.ws + WS_MOD) + (size_t)b * 12288 + 10240) + F.lane;
#pragma unroll
    for (int j = 0; j < 8; ++j) g2[j] = gp[64 * j];
}
__device__ __forceinline__ void p9_row(const Frame& F, int m, const P9Row& R, const f32x4 (&g2)[8], const f32x4 (&fg)[8]) {
    f32x4 v[8]; float s = 0.f;
#pragma unroll
    for (int j = 0; j < 8; ++j) {
        f32x4 mo = {0.f, 0.f, 0.f, 0.f};
#pragma unroll
        for (int k = 0; k < 4; ++k) { const unsigned cw = R.cw[j][k];
            const f32x2 lo = __builtin_amdgcn_cvt_pk_f32_fp8(cw, false), hi = __builtin_amdgcn_cvt_pk_f32_fp8(cw, true);
            mo.x += lo.x; mo.y += lo.y; mo.z += hi.x; mo.w += hi.y; }
        mo = mo * 0.0625f;
        const v2u dw = R.d[j];
        v[j] = (f32x4){bflo(dw.x), bfhi(dw.x), bflo(dw.y), bfhi(dw.y)} + g2[j] * mo;
        s += (v[j].x * v[j].x + v[j].y * v[j].y) + (v[j].z * v[j].z + v[j].w * v[j].w);
    }
    const float rstd = 1.0f / sqrtf(wave_sum(s) * (1.0f / DM) + EPS);
    f32x4* o = (f32x4*)(F.out + (size_t)m * DM) + F.lane;
#pragma unroll
    for (int j = 0; j < 8; ++j) __builtin_nontemporal_store(v[j] * rstd * fg[j], o + 64 * j);
}
__device__ __forceinline__ void p9_final(Frame& F) {
    const int gw = F.vcu * NWAVES + F.wave, NGW = F.G * NWAVES;
    f32x4 fg[8], g2[8]; int bc = -1;
    { const f32x4* fp = (const f32x4*)F.final_g + F.lane;
#pragma unroll
      for (int j = 0; j < 8; ++j) fg[j] = fp[64 * j]; }
    for (int m = gw; m < MTOK; m += 2 * NGW) {
        const int m2 = m + NGW; const bool two = m2 < MTOK;
        P9Row RA, RB;
        p9_load(F, m, RA);
        if (two) p9_load(F, m2, RB);
        if ((m >> 12) != bc) { bc = m >> 12; p9_gate(F, bc, g2); }
        p9_row(F, m, RA, g2, fg);
        if (two) { if ((m2 >> 12) != bc) { bc = m2 >> 12; p9_gate(F, bc, g2); } p9_row(F, m2, RB, g2, fg); }
    }
}

struct Args { const float* in[16]; float* out; unsigned char* ws; int ph_lo, ph_hi, li, pad; };
__global__ void __launch_bounds__(NWAVES * 64, 2) mega_fwd(Args args) {
    extern __shared__ __attribute__((aligned(16))) unsigned char lds[];
    Frame F;
    F.lds = (LAS unsigned char*)lds;
    F.tid = threadIdx.x; F.lane = F.tid & 63; F.wave = __builtin_amdgcn_readfirstlane(F.tid >> 6);
    F.G = gridDim.x; { const int bx = blockIdx.x; F.vcu = (F.G % 8 == 0) ? (bx % 8) * (F.G / 8) + bx / 8 : bx; }
    F.ws = args.ws; F.ctl = (unsigned*)(args.ws + WS_CTL); F.out = args.out;
    F.x = args.in[0]; F.c = args.in[1]; F.norm1_g = args.in[2]; F.w_mod = args.in[3]; F.b_mod = args.in[4]; F.w_in = args.in[5]; F.conv_w = args.in[6]; F.w_out = args.in[7];
    F.norm2_g = args.in[8]; F.w_router = args.in[9]; F.b_router = args.in[10]; F.w_gu = args.in[11]; F.b_gu = args.in[12]; F.w_dn = args.in[13]; F.b_dn = args.in[14]; F.final_g = args.in[15];
    volatile LAS unsigned* MISC = (volatile LAS unsigned*)(F.lds + MISC_OFF);
    for (int u = F.tid; u < (LDS_BYTES - LDSCTL_OFF) / 4; u += NWAVES * 64) ((LAS unsigned*)(F.lds + LDSCTL_OFF))[u] = 0u;
    __syncthreads();
    XcdBarrier bar; bar.bar = F.ctl + CW_BAR; bar.x = 0; bar.st = nullptr;
    if (N_LAUNCHES != PER_PHASE) bar = xcd_barrier_post(F.ctl + CW_BAR, MISC + 8);
#define GRID_BAR() do { if (N_LAUNCHES != PER_PHASE) xcd_barrier(bar); } while (0)
    const int lo = args.ph_lo, hi = args.ph_hi;
#define IN(k) (lo <= (k) && (k) < hi)
#define BOTH(k) (IN(k) && IN((k) + 1))
    LAS int* TP = (LAS int*)(F.lds + LDSCTL_OFF + 448);
    LAS int* CN = TP + 40;
    LAS int* TE = (LAS int*)(F.lds + LDSCTL_OFF + 8192);

    if (IN(0)) { RUN(0, p0_prologue(F)); if (BOTH(0)) GRID_BAR(); }
    if (IN(1)) { RUN(1, p1_norm1(F)); if (BOTH(1)) GRID_BAR(); }
    LAS int* QSLOT = (LAS int*)(F.lds + LDSCTL_OFF + 768);
    const int xcd_ = F.vcu >> 5, jx_ = F.vcu & 31;
    if (IN(2)) {
        constexpr int NCX = NCONV2;
        const bool split = (F.G == 256);
        if (!split || jx_ >= NCX) {
            pg8::DenseOrder S; if (split) S.init(DM * 2, MTOK, NPROJ, (32 - NCX) * 8, (jx_ - NCX) * 8 + xcd_); else S.init(DM * 2, MTOK, NPROJ, F.G, (int)blockIdx.x);
            pg8::EpiProj E{0x7f7f7f7f, (bf16*)(F.ws + WS_PROJ), NPROJ};
            RUN(2, pg8::gemm_phase<pg8::EpiProj, pg8::DenseOrder, false>(F.lds, F.ws + WS_H, F.ws + WS_WIN, DM * 2, NPROJ, S, E));
            if (F.tid == 0) __hip_atomic_fetch_add(F.ctl + CW_DONE2, 1u, __ATOMIC_RELAXED, __HIP_MEMORY_SCOPE_AGENT);
        }
        if (split) conv_pull(F, QSLOT, false, F.ctl + CW_DONE2, (unsigned)((32 - NCX) * 8));
        if (BOTH(2)) GRID_BAR();
    }
    if (IN(3)) { RUN(3, p3a_scan_conv(F)); GRID_BAR(); p3b_carry(F); if (BOTH(3)) GRID_BAR(); }
    if (IN(4)) { RUN(4, p4_retention(F)); if (BOTH(4)) GRID_BAR(); }
    if (IN(5)) {
        constexpr int NCX = NCONV5;
        const bool split = (F.G == 256);
        if (!split || jx_ >= NCX) {
            constexpr int KBO = OUT_FP8 ? DM : DM * 2;
            pg8::DenseOrder S; if (split) S.init(KBO, MTOK, DM, (32 - NCX) * 8, (jx_ - NCX) * 8 + xcd_); else S.init(KBO, MTOK, DM, F.G, (int)blockIdx.x);
            pg8::EpiDelta E{OUT_FP8 ? 0x79797979 : 0x7f7f7f7f, (const float*)(F.ws + WS_MOD), (bf16*)(F.ws + WS_X1)};
            RUN(5, pg8::gemm_phase<pg8::EpiDelta, pg8::DenseOrder, OUT_FP8 != 0>(F.lds, F.ws + WS_Y, F.ws + WS_WOUT, KBO, DM, S, E));
            if (F.tid == 0) __hip_atomic_fetch_add(F.ctl + CW_DONE5, 1u, __ATOMIC_RELAXED, __HIP_MEMORY_SCOPE_AGENT);
        }
        if (split) conv_pull(F, QSLOT, false, F.ctl + CW_DONE5, (unsigned)((32 - NCX) * 8));
        if (BOTH(5)) GRID_BAR();
    }
    if (IN(6)) { RUN(6, p6a_router(F)); if (BOTH(6)) GRID_BAR(); }
    if (IN(7)) { RUN(7, p6b_dispatch(F)); if (BOTH(7)) GRID_BAR(); }
    if (IN(8)) {
        const bool split = (F.G == 256);
        if (N_LAUNCHES == PER_PHASE) moe_table(F, TP, CN);
        int NCX = NCONV8;
        { const int U = TP[NEXP] * 16, R = (U + (255 - 8 * NCONV8)) / (256 - 8 * NCONV8);
          if (R > 0) { const int gp = (((U + R - 1) / R) + 7) & ~7; NCX = 32 - gp / 8; if (NCX < NCONV8) NCX = NCONV8; if (NCX > 16) NCX = 16; } }
        if (!split || jx_ >= NCX) {
            pg8::MoeOrder S{TP, CN, 16, split ? (32 - NCX) * 8 : F.G, split ? xcd_ * (32 - NCX) + (jx_ - NCX) : F.vcu, (unsigned)(DM * 2 * DFF * MOE_ES), 1, (const int*)(F.ws + WS_DEST), TE};
            pg8::EpiGateUp E{0x79797979, F.b_gu, F.ws + WS_ACT};
            RUN(8, pg8::gemm_phase<pg8::EpiGateUp, pg8::MoeOrder, MOE_FP8 != 0, true>(F.lds, F.ws + WS_H, F.ws + WS_WGU, DM * MOE_ES, 2 * DFF, S, E));
        }
        conv_pull(F, QSLOT, true, nullptr, 0u);
        if (BOTH(8)) GRID_BAR();
    }
    if (IN(9)) {
        if (N_LAUNCHES == PER_PHASE) moe_table(F, TP, CN);
        pg8::MoeOrder S{TP, CN, 8, F.G, F.vcu, (unsigned)(DFF * DM * MOE_ES), 0, nullptr, TE};
        pg8::EpiDown E{0x79797979, F.b_dn, (const int*)(F.ws + WS_DEST), (const float*)(F.ws + WS_WROW), F.ws + WS_CONTRIB};
        RUN(9, pg8::gemm_phase<pg8::EpiDown, pg8::MoeOrder, MOE_FP8 != 0>(F.lds, F.ws + WS_ACT, F.ws + WS_WDN, DFF * MOE_ES, DM, S, E));
        if (BOTH(9)) GRID_BAR();
    }
    if (IN(10)) { RUN(10, p9_final(F)); }
#undef IN
#undef BOTH
}

extern "C" void kernel_launch(void* const* d_in, const int* in_sizes, int n_in, void* d_out, int out_size, void* d_ws, size_t ws_size, hipStream_t stream) {
    static int grid = 0;
    if (grid == 0) {
        if (n_in != 16 || out_size != MTOK * DM || ws_size < WS_END) { fprintf(stderr, "kernel_launch: unexpected shapes (n_in %d out %d ws %zu)\n", n_in, out_size, ws_size); grid = -1; return; }
        int dev = 0, cus = 0, per_cu = 0;
        if (hipGetDevice(&dev) != hipSuccess || hipDeviceGetAttribute(&cus, hipDeviceAttributeMultiprocessorCount, dev) != hipSuccess) { grid = -1; return; }
        if (hipFuncSetAttribute((const void*)mega_fwd, hipFuncAttributeMaxDynamicSharedMemorySize, LDS_BYTES) != hipSuccess) { grid = -1; return; }
        if (hipOccupancyMaxActiveBlocksPerMultiprocessor(&per_cu, (const void*)mega_fwd, NWAVES * 64, LDS_BYTES) != hipSuccess || per_cu < 1)
            fprintf(stderr, "kernel_launch: occupancy query reports %d workgroups per CU\n", per_cu);
        (void)hipGetLastError();
        grid = cus;
    }
    if (grid < 0) return;
    if (hipMemsetAsync((char*)d_ws + WS_CTL, 0, CTL_ZERO_BYTES, stream) != hipSuccess) return;
    Args a{};
    for (int i = 0; i < 16; ++i) a.in[i] = (const float*)d_in[i];
    a.out = (float*)d_out; a.ws = (unsigned char*)d_ws;
    for (int li = 0; li < N_LAUNCHES; ++li) {
        a.ph_lo = (N_LAUNCHES == PER_PHASE) ? li : 0; a.ph_hi = (N_LAUNCHES == PER_PHASE) ? li + 1 : PER_PHASE; a.li = li; a.pad = 0;
        hipLaunchKernelGGL(mega_fwd, dim3(grid), dim3(NWAVES * 64), LDS_BYTES, stream, a);
        const hipError_t le = hipPeekAtLastError();
        if (le != hipSuccess) { fprintf(stderr, "kernel_launch: launch %d failed: %s\n", li, hipGetErrorName(le)); break; }
    }
}
```
